# Optimizing an MI355X kernel written in HIP

```python
import jax
import jax.numpy as jnp
from jax import lax
import numpy as np

D_MODEL = 1024
BATCH = 16
SEQ = 2048
DEPTH = 2

CTX_LEN = 256
GRID_W = 64
EPS = 1e-6
F32 = jnp.float32

MLSTM_HEADS = 4
MLSTM_HEAD_DIM = 64
MLSTM_WIDTH = MLSTM_HEADS * MLSTM_HEAD_DIM
MLSTM_CHUNK = 128
MLA_HEADS = 8
MLA_Q_RANK = 256
MLA_KV_RANK = 128
MLA_NOPE_DIM = 64
MLA_ROPE_DIM = 32
MLA_V_DIM = 64
MLA_QK_DIM = MLA_NOPE_DIM + MLA_ROPE_DIM
MLA_WIDTH = MLA_HEADS * MLA_V_DIM
ROPE_BASE = 10000.0
ATTN_BLOCK = 128
GMLP_GROUPS = 4
GMLP_GROUP_DIM = 64
GMLP_WIDTH = GMLP_GROUPS * GMLP_GROUP_DIM
GMLP_CHUNK = 128
MIX_WIDTH = MLSTM_WIDTH + MLA_WIDTH + GMLP_WIDTH

OFF_QA = 0
OFF_KA = OFF_QA + MLSTM_WIDTH
OFF_VA = OFF_KA + MLSTM_WIDTH
OFF_OA = OFF_VA + MLSTM_WIDTH
OFF_GA = OFF_OA + MLSTM_WIDTH
OFF_CQ = OFF_GA + 4 * MLSTM_HEADS
OFF_CKV = OFF_CQ + MLA_Q_RANK
OFF_KR = OFF_CKV + MLA_KV_RANK
OFF_GM = OFF_KR + MLA_ROPE_DIM
IN_COLS = OFF_GM + 2 * GMLP_WIDTH

D_FF = 2816
N_EXPERTS = 8
TOP_K = 2
D_FF_EXPERT = 3584
MOE_BLOCK = 512
N_DENSE = (DEPTH + 1) // 2
N_MOE = DEPTH // 2

kernel_name = 'hybrid_mlstm_mla_gmlp_moe_block'


def rms_norm(x, g):
    xf = x.astype(F32)
    y = xf * lax.rsqrt(jnp.mean(xf * xf, axis=-1, keepdims=True) + EPS)
    return y.astype(x.dtype) * g


def layer_norm(x, g, b):
    xf = x.astype(F32)
    mu = jnp.mean(xf, axis=-1, keepdims=True)
    var = jnp.mean(jnp.square(xf - mu), axis=-1, keepdims=True)
    return ((xf - mu) * lax.rsqrt(var + EPS)).astype(x.dtype) * g + b


def axial_rope(rows):
    row = jnp.repeat(jnp.arange(rows), GRID_W).astype(F32)
    col = jnp.tile(jnp.arange(GRID_W), rows).astype(F32)
    n_freq = MLA_ROPE_DIM // 4
    inv = ROPE_BASE ** (-jnp.arange(n_freq, dtype=F32) / n_freq)
    ang = jnp.concatenate([row[:, None] * inv, col[:, None] * inv], axis=-1)
    return jnp.cos(ang), jnp.sin(ang)


def apply_rope(t, cos, sin):
    half = t.shape[-1] // 2
    t1, t2 = t[..., :half], t[..., half:]
    cos = cos[None, :, None, :].astype(t.dtype)
    sin = sin[None, :, None, :].astype(t.dtype)
    return jnp.concatenate([t1 * cos - t2 * sin, t1 * sin + t2 * cos], axis=-1)


def mlstm_scan(q, k, v, log_i, log_f, state, with_h):
    bsz, t_len, heads, e = q.shape
    L = MLSTM_CHUNK
    nc = t_len // L

    def chunks(a):
        return jnp.moveaxis(a.reshape((bsz, nc, L) + a.shape[2:]), 1, 0)

    scan_order = jnp.tril(jnp.ones((L, L), bool))

    def step(carry, inp):
        C, n, m = carry
        qc, kc, vc, ic, fc = inp
        b = jnp.cumsum(fc, axis=1).transpose(0, 2, 1)
        ig = ic.transpose(0, 2, 1)
        b_last = b[:, :, -1]
        g = b_last[..., None] - b + ig
        m_new = jnp.maximum(b_last + m, jnp.max(g, axis=-1))
        w = jnp.exp(g - m_new[..., None])
        decay = jnp.exp(b_last + m - m_new)
        C_new = decay[..., None, None] * C + jnp.einsum('bhs,bshd,bshe->bhde', w, kc, vc)
        n_new = decay[..., None] * n + jnp.einsum('bhs,bshd->bhd', w, kc)
        if not with_h:
            return (C_new, n_new, m_new), None
        dmat = b[..., :, None] - b[..., None, :] + ig[..., None, :]
        dmat = jnp.where(scan_order, dmat, -jnp.inf)
        inter = b + m[..., None]
        m_t = jnp.maximum(inter, jnp.max(dmat, axis=-1))
        s = jnp.einsum('blhd,bshd->bhls', qc, kc) * jnp.exp(dmat - m_t[..., None])
        a = jnp.exp(inter - m_t)
        num = jnp.einsum('bhls,bshe->bhle', s, vc) + a[..., None] * jnp.einsum('blhd,bhde->bhle', qc, C)
        den = jnp.sum(s, axis=-1) + a * jnp.einsum('blhd,bhd->bhl', qc, n)
        h = num / jnp.maximum(jnp.abs(den), jnp.exp(-m_t))[..., None]
        return (C_new, n_new, m_new), h.transpose(0, 2, 1, 3)

    state, hs = lax.scan(step, state, (chunks(q), chunks(k), chunks(v), chunks(log_i), chunks(log_f)))
    if not with_h:
        return state, None
    return state, jnp.moveaxis(hs, 0, 1).reshape(bsz, t_len, heads, e)


def mlstm_split(z, gate_b):
    bsz, t_len, _ = z.shape

    def heads(a):
        return a.reshape(bsz, t_len, MLSTM_HEADS, MLSTM_HEAD_DIM).astype(F32)

    q = heads(z[..., OFF_QA:OFF_KA])
    k = heads(z[..., OFF_KA:OFF_VA]) * (MLSTM_HEAD_DIM ** -0.5)
    v = heads(z[..., OFF_VA:OFF_OA])
    o = jax.nn.sigmoid(z[..., OFF_OA:OFF_GA])
    gates = (z[..., OFF_GA:OFF_CQ] + gate_b).astype(F32).reshape(bsz, t_len, 4, MLSTM_HEADS)
    log_i = gates[:, :, 0:2]
    log_f = jax.nn.log_sigmoid(gates[:, :, 2:4])
    return q, k, v, o, log_i, log_f


def mlstm_mixer(z_lat, z_ctx, gate_b, norm_g, with_ctx_out):
    ql, kl, vl, ol, il, fl = mlstm_split(z_lat, gate_b)
    qc, kc, vc, oc, ic, fc = mlstm_split(z_ctx, gate_b)
    bsz = z_lat.shape[0]
    zero_state = (jnp.zeros((bsz, MLSTM_HEADS, MLSTM_HEAD_DIM, MLSTM_HEAD_DIM), F32),
                  jnp.zeros((bsz, MLSTM_HEADS, MLSTM_HEAD_DIM), F32),
                  jnp.zeros((bsz, MLSTM_HEADS), F32))
    g = norm_g.reshape(MLSTM_HEADS, MLSTM_HEAD_DIM)
    h_lat = 0.0
    h_ctx = 0.0
    for d in range(2):
        rev = d == 1
        fl_ = (lambda a: jnp.flip(a, axis=1)) if rev else (lambda a: a)
        ctx_state, hc = mlstm_scan(fl_(qc), fl_(kc), fl_(vc), fl_(ic[:, :, d]), fl_(fc[:, :, d]),
                                   zero_state, with_ctx_out)
        _, hl = mlstm_scan(fl_(ql), fl_(kl), fl_(vl), fl_(il[:, :, d]), fl_(fl[:, :, d]), ctx_state, True)
        h_lat = h_lat + fl_(hl)
        if with_ctx_out:
            h_ctx = h_ctx + fl_(hc)
    bl, tl = z_lat.shape[:2]
    out_lat = (ol * rms_norm(h_lat, g).reshape(bl, tl, MLSTM_WIDTH)).astype(z_lat.dtype)
    if not with_ctx_out:
        return out_lat, None
    tc = z_ctx.shape[1]
    out_ctx = (oc * rms_norm(h_ctx, g).reshape(bl, tc, MLSTM_WIDTH)).astype(z_ctx.dtype)
    return out_lat, out_ctx


def with_rope(t, rope):
    return jnp.concatenate([t[..., :MLA_NOPE_DIM], apply_rope(t[..., MLA_NOPE_DIM:], rope[0], rope[1])], axis=-1)


def mla_queries(z, cq_g, w_uq, q_g, rope):
    bsz, t_len, _ = z.shape
    q = (rms_norm(z[..., OFF_CQ:OFF_CKV], cq_g) @ w_uq).reshape(bsz, t_len, MLA_HEADS, MLA_QK_DIM)
    q = rms_norm(q, q_g)
    return q if rope is None else with_rope(q, rope)


def mla_keys_values(z, ckv_g, w_ukv, k_g, rope):
    bsz, t_len, _ = z.shape
    kv = (rms_norm(z[..., OFF_CKV:OFF_KR], ckv_g) @ w_ukv).reshape(bsz, t_len, MLA_HEADS, MLA_NOPE_DIM + MLA_V_DIM)
    k_rope = jnp.broadcast_to(z[..., None, OFF_KR:OFF_GM], (bsz, t_len, MLA_HEADS, MLA_ROPE_DIM))
    k = rms_norm(jnp.concatenate([kv[..., :MLA_NOPE_DIM], k_rope], axis=-1), k_g)
    v = kv[..., MLA_NOPE_DIM:]
    k = k if rope is None else with_rope(k, rope)
    return k, v


def attention(q, k, v):
    s = jnp.einsum('bqhd,bkhd->bhqk', q, k).astype(F32) * (MLA_QK_DIM ** -0.5)
    p = jax.nn.softmax(s, axis=-1).astype(v.dtype)
    return jnp.einsum('bhqk,bkhd->bqhd', p, v)


def blocked_attention(q, k, v):
    bsz, t_len, heads, dq = q.shape
    nb = t_len // ATTN_BLOCK
    qb = jnp.moveaxis(q.reshape(bsz, nb, ATTN_BLOCK, heads, dq), 1, 0)
    ob = lax.map(lambda qq: attention(qq, k, v), qb)
    return jnp.moveaxis(ob, 0, 1).reshape(bsz, t_len, heads * v.shape[-1])


def gmlp_mixer(z, ln_g, ln_b, w_s, b_s):
    bsz, t_len, _ = z.shape
    a = jax.nn.gelu(z[..., OFF_GM:IN_COLS])
    u, v = a[..., :GMLP_WIDTH], a[..., GMLP_WIDTH:]
    v = layer_norm(v, ln_g, ln_b).reshape(bsz, t_len // GMLP_CHUNK, GMLP_CHUNK, GMLP_GROUPS, GMLP_GROUP_DIM)
    sv = jnp.einsum('gpq,bcqgd->bcpgd', w_s, v) + b_s.T[None, None, :, :, None]
    return u * sv.reshape(bsz, t_len, GMLP_WIDTH)


def swiglu(h, w1, w3, w2):
    return (jax.nn.silu(h @ w1) * (h @ w3)) @ w2


def moe_swiglu(h, router_w, router_b, w1, w3, w2):
    d = h.shape[-1]
    hf = h.reshape(-1, d)
    n = hf.shape[0]
    logits = (hf @ router_w).astype(F32) + router_b.astype(F32)
    top_logit, top_idx = lax.top_k(logits, TOP_K)
    gates = jax.nn.softmax(top_logit, axis=-1).astype(h.dtype)
    flat_e = top_idx.reshape(-1)
    flat_tok = jnp.repeat(jnp.arange(n, dtype=jnp.int32), TOP_K)
    order = jnp.argsort(flat_e)
    sorted_e = flat_e[order]
    counts = jnp.bincount(flat_e, length=N_EXPERTS)
    padded = (counts + MOE_BLOCK - 1) // MOE_BLOCK * MOE_BLOCK
    padded_end = jnp.cumsum(padded)
    rank = jnp.arange(n * TOP_K) - (jnp.cumsum(counts) - counts)[sorted_e]
    dest = (padded_end - padded)[sorted_e] + rank
    cap = (n * TOP_K + MOE_BLOCK - 1) // MOE_BLOCK * MOE_BLOCK + N_EXPERTS * MOE_BLOCK
    slot_tok = jnp.zeros((cap,), jnp.int32).at[dest].set(flat_tok[order])
    slot_gate = jnp.zeros((cap,), h.dtype).at[dest].set(gates.reshape(-1)[order])
    n_blocks = cap // MOE_BLOCK
    block_expert = jnp.minimum(
        jnp.searchsorted(padded_end, jnp.arange(n_blocks) * MOE_BLOCK, side='right'), N_EXPERTS - 1)
    xb = hf[slot_tok].reshape(n_blocks, MOE_BLOCK, d)

    def expert_block(args):
        xe, e = args
        return swiglu(xe, w1[e], w3[e], w2[e])

    yb = lax.map(expert_block, (xb, block_expert))
    y = jax.ops.segment_sum(yb.reshape(cap, d) * slot_gate[:, None], slot_tok, num_segments=n)
    return y.reshape(h.shape)


def channel_mixer(layer, h, ffn_w1, ffn_w3, ffn_w2, moe_router_w, moe_router_b, moe_w1, moe_w3, moe_w2):
    j = layer // 2
    if layer % 2 == 0:
        return swiglu(h, ffn_w1[j], ffn_w3[j], ffn_w2[j])
    return moe_swiglu(h, moe_router_w[j], moe_router_b[j], moe_w1[j], moe_w3[j], moe_w2[j])


def setup_inputs(seed: int = 0) -> dict:
    key = jax.random.key(seed)
    ks = iter(jax.random.split(key, 40))
    D = D_MODEL

    def nrm(shape, scale):
        return jax.random.normal(next(ks), shape, F32) * scale

    def gain(shape):
        return 1.0 + nrm(shape, 0.02)

    f_bias = jnp.tile(jnp.linspace(3.0, 6.0, MLSTM_HEADS), 2)[None, :] + nrm((DEPTH, 2 * MLSTM_HEADS), 0.1)
    i_bias = nrm((DEPTH, 2 * MLSTM_HEADS), 0.1)
    return {
        'x': nrm((BATCH, SEQ, D), 1.0),
        'c': nrm((BATCH, D), 1.0),
        'ctx': nrm((BATCH, CTX_LEN, D), 1.0),
        'c_ctx': nrm((D,), 1.0),
        'ada_w': nrm((DEPTH, D, 6 * D), 0.5 * D ** -0.5),
        'ada_b': nrm((DEPTH, 6 * D), 0.02),
        'norm1_g': gain((DEPTH, D)),
        'norm2_g': gain((DEPTH, D)),
        'w_in': nrm((DEPTH, D, IN_COLS), D ** -0.5),
        'w_out': nrm((DEPTH, MIX_WIDTH, D), MIX_WIDTH ** -0.5),
        'mlstm_gate_b': jnp.concatenate([i_bias, f_bias], axis=-1),
        'mlstm_norm_g': gain((DEPTH, MLSTM_WIDTH)),
        'mla_cq_g': gain((DEPTH, MLA_Q_RANK)),
        'mla_ckv_g': gain((DEPTH, MLA_KV_RANK)),
        'mla_w_uq': nrm((DEPTH, MLA_Q_RANK, MLA_HEADS * MLA_QK_DIM), MLA_Q_RANK ** -0.5),
        'mla_w_ukv': nrm((DEPTH, MLA_KV_RANK, MLA_HEADS * (MLA_NOPE_DIM + MLA_V_DIM)), MLA_KV_RANK ** -0.5),
        'mla_q_g': gain((DEPTH, MLA_QK_DIM)),
        'mla_k_g': gain((DEPTH, MLA_QK_DIM)),
        'gmlp_ln_g': gain((DEPTH, GMLP_WIDTH)),
        'gmlp_ln_b': nrm((DEPTH, GMLP_WIDTH), 0.02),
        'gmlp_w_s': nrm((DEPTH, GMLP_GROUPS, GMLP_CHUNK, GMLP_CHUNK), GMLP_CHUNK ** -0.5),
        'gmlp_b_s': gain((DEPTH, GMLP_GROUPS, GMLP_CHUNK)),
        'ffn_w1': nrm((N_DENSE, D, D_FF), D ** -0.5),
        'ffn_w3': nrm((N_DENSE, D, D_FF), D ** -0.5),
        'ffn_w2': nrm((N_DENSE, D_FF, D), D_FF ** -0.5),
        'moe_router_w': nrm((N_MOE, D, N_EXPERTS), D ** -0.5),
        'moe_router_b': nrm((N_MOE, N_EXPERTS), 0.01),
        'moe_w1': nrm((N_MOE, N_EXPERTS, D, D_FF_EXPERT), D ** -0.5),
        'moe_w3': nrm((N_MOE, N_EXPERTS, D, D_FF_EXPERT), D ** -0.5),
        'moe_w2': nrm((N_MOE, N_EXPERTS, D_FF_EXPERT, D), D_FF_EXPERT ** -0.5),
    }


def reference(x, c, ctx, c_ctx, ada_w, ada_b, norm1_g, norm2_g, w_in, w_out, mlstm_gate_b, mlstm_norm_g,
              mla_cq_g, mla_ckv_g, mla_w_uq, mla_w_ukv, mla_q_g, mla_k_g, gmlp_ln_g, gmlp_ln_b, gmlp_w_s,
              gmlp_b_s, ffn_w1, ffn_w3, ffn_w2, moe_router_w, moe_router_b, moe_w1, moe_w3, moe_w2):
    rows = x.shape[1] // GRID_W
    rope = axial_rope(rows)
    ffn = (ffn_w1, ffn_w3, ffn_w2, moe_router_w, moe_router_b, moe_w1, moe_w3, moe_w2)
    xc = ctx
    for l in range(DEPTH):
        last = l == DEPTH - 1
        sh1, sc1, g1, sh2, sc2, g2 = jnp.split((jax.nn.silu(c) @ ada_w[l] + ada_b[l])[:, None, :], 6, axis=-1)
        sh1c, sc1c, g1c, sh2c, sc2c, g2c = jnp.split(jax.nn.silu(c_ctx) @ ada_w[l] + ada_b[l], 6, axis=-1)
        z = (rms_norm(x, norm1_g[l]) * (1.0 + sc1) + sh1) @ w_in[l]
        zc = (rms_norm(xc, norm1_g[l]) * (1.0 + sc1c) + sh1c) @ w_in[l]
        a_lat, a_ctx = mlstm_mixer(z, zc, mlstm_gate_b[l], mlstm_norm_g[l], not last)
        k_lat, v_lat = mla_keys_values(z, mla_ckv_g[l], mla_w_ukv[l], mla_k_g[l], rope)
        k_ctx, v_ctx = mla_keys_values(zc, mla_ckv_g[l], mla_w_ukv[l], mla_k_g[l], None)
        q_lat = mla_queries(z, mla_cq_g[l], mla_w_uq[l], mla_q_g[l], rope)
        b_lat = blocked_attention(q_lat, jnp.concatenate([k_lat, k_ctx], axis=1),
                                  jnp.concatenate([v_lat, v_ctx], axis=1))
        c_lat = gmlp_mixer(z, gmlp_ln_g[l], gmlp_ln_b[l], gmlp_w_s[l], gmlp_b_s[l])
        x = x + g1 * (jnp.concatenate([a_lat, b_lat, c_lat], axis=-1) @ w_out[l])
        x = x + g2 * channel_mixer(l, rms_norm(x, norm2_g[l]) * (1.0 + sc2) + sh2, *ffn)
        if not last:
            q_ctx = mla_queries(zc, mla_cq_g[l], mla_w_uq[l], mla_q_g[l], None)
            b_ctx = attention(q_ctx, k_ctx, v_ctx).reshape(xc.shape[0], xc.shape[1], MLA_WIDTH)
            c_ctx_out = gmlp_mixer(zc, gmlp_ln_g[l], gmlp_ln_b[l], gmlp_w_s[l], gmlp_b_s[l])
            xc = xc + g1c * (jnp.concatenate([a_ctx, b_ctx, c_ctx_out], axis=-1) @ w_out[l])
            xc = xc + g2c * channel_mixer(l, rms_norm(xc, norm2_g[l]) * (1.0 + sc2c) + sh2c, *ffn)
    return x
```

```cpp
#include <hip/hip_runtime.h>
#include <cstdio>
#include <cstdint>

#define GAS __attribute__((address_space(1)))
#define LAS __attribute__((address_space(3)))
#define DI __device__ __forceinline__
typedef unsigned short bf16_t;
typedef short bf16x8 __attribute__((ext_vector_type(8)));
typedef __bf16 bf16x2_t __attribute__((ext_vector_type(2)));
typedef float f32x4 __attribute__((ext_vector_type(4)));
typedef float f32x2 __attribute__((ext_vector_type(2)));
typedef unsigned u32x4 __attribute__((ext_vector_type(4)));
typedef unsigned u32x2 __attribute__((ext_vector_type(2)));
typedef int i32x8 __attribute__((ext_vector_type(8)));
typedef int i32x4 __attribute__((ext_vector_type(4)));

#ifndef ONE_LAUNCH
#define ONE_LAUNCH 1
#endif

constexpr int D = 1024, NB = 16, SEQ = 2048, CTXL = 256;
constexpr int NLAT = NB * SEQ, NCTX = NB * CTXL, NTOK = NLAT + NCTX;
constexpr int IN_COLS = 1968;
constexpr int ZW = 2048;
constexpr int ZQA = 0, ZKA = 256, ZVA = 512, ZOA = 768, ZCQ = 1024, ZCKV = 1280, ZKR = 1408, ZGA = 1440, ZGU = 1536, ZGV = 1792;
constexpr int UPK = 384, UPN = 1792;
constexpr int DFF = 2816, DFFE = 3584, NE = 8;
constexpr int TB = 176, MAXT = 264, NBATCH = 2;
constexpr float EPS = 1e-6f;
constexpr float H8_SCALE = 8.0f, W8_SCALE = 32.0f, G8_SCALE = 4.0f, W28_SCALE = 64.0f;
constexpr float QSCALE = 0.10206207261596577f * 1.4426950408889634f;

constexpr size_t MiB = 1u << 20;
constexpr size_t WS_CTL = 0, CTL_ZERO_BYTES = 1 * MiB;
constexpr size_t WS_MOD = 1 * MiB;
constexpr size_t WS_TOPI = 2 * MiB, WS_TOPG = WS_TOPI + 262144, WS_TOKSLOT = WS_TOPG + 262144, WS_SLOTTOK = WS_TOKSLOT + 262144;
constexpr size_t WS_GS = 2 * MiB;
constexpr size_t WS_XC = 6 * MiB;
constexpr size_t WS_WIN = 14 * MiB, WS_WOUT = 22 * MiB, WS_BUP = 26 * MiB, WS_W13D = 29 * MiB, WS_W2D = 40 * MiB, WS_WS = 46 * MiB;
constexpr size_t WS_XN = 48 * MiB;
constexpr size_t WS_BIG = 120 * MiB;
constexpr size_t WS_Z = WS_BIG, WS_QKV = 264 * MiB, WS_KF = 390 * MiB, WS_HD = 444 * MiB, WS_VLN = 482 * MiB;
constexpr size_t WS_QM = 500 * MiB;
constexpr size_t WS_G0 = WS_BIG;
constexpr size_t WS_X3 = WS_BIG, WS_Y = 184 * MiB, WS_GM = 316 * MiB;
constexpr size_t WS_W13M = 503 * MiB, WS_W2M = 559 * MiB;
constexpr size_t WS_END = 587 * MiB;
static_assert(WS_VLN + (size_t)NTOK * 256 * 2 <= WS_QM && WS_QM + (size_t)NTOK * 8 * 4 <= WS_W13M && WS_GM + (size_t)TB * 256 * DFFE <= WS_W13M && WS_Y + (size_t)MAXT * 256 * D * 2 <= WS_GM && WS_X3 + (size_t)NLAT * D * 2 <= WS_Y, "ws map");
static_assert(WS_G0 + (size_t)NTOK * DFF * 2 <= WS_W13M && WS_HD + (size_t)NB * 4 * 18 * 2 * 4224 * 4 <= WS_VLN && WS_W2M + (size_t)NE * D * DFFE <= WS_END && WS_W13M + (size_t)NE * 2 * DFFE * D <= WS_W2M && WS_Z + (size_t)NTOK * ZW * 2 <= WS_QKV && WS_QKV + (size_t)NTOK * UPN * 2 <= WS_KF && WS_KF + (size_t)NTOK * 768 * 2 <= WS_HD, "ws map 2");
constexpr int CW_BAR = 4096;
constexpr int CW_NT = 16384;
constexpr int CW_TEXP = 16448;
constexpr int CW_BCNT = 32768;

constexpr int LDS_BYTES = 147456, LDSCTL_OFF = 131072;

DI float bf2f(unsigned short b) { return __uint_as_float((unsigned)b << 16); }
DI unsigned f2bf(float f) { unsigned u = __float_as_uint(f); return (u + 0x7fffu + ((u >> 16) & 1u)) >> 16; }
DI unsigned pk2(float lo, float hi) { return f2bf(lo) | (f2bf(hi) << 16); }
DI float lo_f(unsigned w) { return __uint_as_float(w << 16); }
DI float hi_f(unsigned w) { return __uint_as_float(w & 0xffff0000u); }
DI float wave_sum(float v) {
#pragma unroll
    for (int o = 1; o < 64; o <<= 1) v += __shfl_xor(v, o);
    return v;
}
DI int wave_sum_i(int v) {
#pragma unroll
    for (int o = 1; o < 64; o <<= 1) v += __shfl_xor(v, o);
    return v;
}
DI float wave_max(float v) {
#pragma unroll
    for (int o = 1; o < 64; o <<= 1) v = fmaxf(v, __shfl_xor(v, o));
    return v;
}
DI float sigmoidf_(float x) { return 1.0f / (1.0f + __expf(-x)); }
DI float gelu_tanh(float x) { const float u = 0.7978845608028654f * (x + 0.044715f * x * x * x); const float t = 1.0f - 2.0f / (__expf(2.0f * u) + 1.0f); return 0.5f * x * (1.0f + t); }
DI float log_sigmoid(float x) { return fminf(x, 0.f) - log1pf(__expf(-fabsf(x))); }

DI int opq_lane() { int x; asm volatile("v_mbcnt_lo_u32_b32 %0, -1, 0\n\tv_mbcnt_hi_u32_b32 %0, -1, %0" : "=v"(x)); return x; }
DI int opq_i(int i) { i = __builtin_amdgcn_readfirstlane(i); asm volatile("" : "+s"(i)); return i; }
DI GAS unsigned char* opq_p(unsigned char* p) { unsigned long long v = (unsigned long long)p; const unsigned lo_ = __builtin_amdgcn_readfirstlane((unsigned)v), hi_ = __builtin_amdgcn_readfirstlane((unsigned)(v >> 32));
    v = ((unsigned long long)hi_ << 32) | lo_; asm volatile("" : "+s"(v)); GAS unsigned char* q = (GAS unsigned char*)v;
    return q; }

#define XB_TMO      128
#define XB_XCNT(j)  (256  + 64 * (j))
#define XB_XSUB(j)  (1280 + 64 * (j))
#define XB_XGEN(j)  (2304 + 64 * (j))
#define XB_TOP      3328
#define XB_TOPGEN   3392
#define XCD_BAR_WORDS 3456
#define XB_SPIN_CAP (1u << 18)
DI unsigned xb_ld(unsigned* p)              { return __hip_atomic_load(p, __ATOMIC_RELAXED, __HIP_MEMORY_SCOPE_AGENT); }
DI unsigned xb_add(unsigned* p, unsigned v) { return __hip_atomic_fetch_add(p, v, __ATOMIC_RELAXED, __HIP_MEMORY_SCOPE_AGENT); }
DI unsigned xb_xcc_id() { return (unsigned)__builtin_amdgcn_s_getreg((3 << 11) | 20) & 0xFu; }
#define XB_SPIN(cond, bar) do { unsigned _sp = 0; while (cond) { __builtin_amdgcn_s_sleep(1); \
    if ((++_sp & 255u) == 0u) { if (xb_ld(&(bar)[XB_TMO])) break; if (_sp > XB_SPIN_CAP) { atomicAdd(&(bar)[XB_TMO], 1u); break; } } } } while (0)
struct XcdBarrier { unsigned* bar; unsigned x; volatile LAS unsigned* st; };
DI XcdBarrier xcd_barrier_post(unsigned* bar, volatile LAS unsigned* st) {
    XcdBarrier b; b.bar = bar; b.x = xb_xcc_id(); b.st = st;
    if (threadIdx.x == 0) (void)xb_add(&bar[XB_XCNT(b.x)], 1u);
    return b;
}
DI void xcd_barrier_complete(unsigned* bar, unsigned x, unsigned& nloc, unsigned& nx) {
    const unsigned G = gridDim.x * gridDim.y * gridDim.z;
    unsigned sum, cnt, mine, sp = 0u;
    for (;;) {
        sum = 0u; cnt = 0u; mine = 0u;
#pragma unroll
        for (unsigned j = 0; j < 16; ++j) { const unsigned c = xb_ld(&bar[XB_XCNT(j)]); sum += c; cnt += (c > 0u) ? 1u : 0u; mine = (j == x) ? c : mine; }
        if (sum == G) break;
        __builtin_amdgcn_s_sleep(1);
        if ((++sp & 255u) == 0u) { if (xb_ld(&bar[XB_TMO])) break; if (sp > XB_SPIN_CAP) { atomicAdd(&bar[XB_TMO], 1u); break; } }
    }
    nloc = mine > 0u ? mine : 1u; nx = cnt > 0u ? cnt : 1u;
}
DI void xcd_barrier(const XcdBarrier& b) {
    asm volatile("s_waitcnt vmcnt(0)" ::: "memory");
    __syncthreads();
    if (threadIdx.x == 0) {
        unsigned* bar = b.bar;
        __builtin_amdgcn_s_waitcnt(0);
        unsigned nloc = b.st[0], nx = b.st[1];
        if (nloc == 0u) { xcd_barrier_complete(bar, b.x, nloc, nx); b.st[0] = nloc; b.st[1] = nx; }
        const unsigned old = xb_add(&bar[XB_XSUB(b.x)], 1u);
        const unsigned gen = old / nloc;
        if (old + 1u == (gen + 1u) * nloc) {
            __builtin_amdgcn_fence(__ATOMIC_RELEASE, "agent");
            asm volatile("s_waitcnt vmcnt(0)" ::: "memory");
            const unsigned og = xb_add(&bar[XB_TOP], 1u);
            const unsigned tg = og / nx;
            if (og + 1u == (tg + 1u) * nx) xb_add(&bar[XB_TOPGEN], 1u);
            else XB_SPIN(xb_ld(&bar[XB_TOPGEN]) == tg, bar);
            __builtin_amdgcn_fence(__ATOMIC_ACQUIRE, "agent");
            xb_add(&bar[XB_XGEN(b.x)], 1u);
            asm volatile("s_waitcnt vmcnt(0)" ::: "memory");
        } else {
            XB_SPIN(xb_ld(&bar[XB_XGEN(b.x)]) == gen, bar);
            __builtin_amdgcn_fence(__ATOMIC_ACQUIRE, "agent");
            asm volatile("s_waitcnt vmcnt(0)" ::: "memory");
        }
    }
    __syncthreads();
}

namespace pg8 {
constexpr int BM = 256, BK = 64, HALF = 128, HTB = HALF * BK * 2, STAGE_BYTES = 8 * HTB, NXCD = 8, WGM = 8;
__host__ __device__ __forceinline__ int lds_byte(int r, int c) { const int st = (r >> 4) * 2 + (c >> 5), rr = r & 15, cc = c & 31, ob = rr * 64 + cc * 2; return st * 1024 + (ob ^ (((ob >> 9) & 1) << 5)); }
__host__ __device__ __forceinline__ void stage_rc(int b, int& R, int& C) { const int st = b / 1024, sb = b % 1024, swz = sb ^ (((sb >> 9) & 1) << 5); R = (st >> 1) * 16 + swz / 64; C = (st & 1) * 32 + (swz % 64) / 2; }
__host__ __device__ __forceinline__ int perm32(int rho) { const int n = rho >> 4, i = rho & 15; return 8 * (i >> 2) + 4 * n + (i & 3); }

struct Unit { int pm, pn, pb, kofs, nt; };
struct Gemm { const GAS bf16_t* A; const GAS bf16_t* Bt; int K, lda; const GAS int* rowidx; };

struct StaticOrder {
    static constexpr bool VARK = false;
    int nM, nN, nwg, G, c;
    DI void init(int M, int N, int G_, int c_) { nM = M / BM; nN = N / BM; nwg = nM * nN; G = G_; c = c_; }
    DI bool next(int i, Unit& u) const {
        const long L = (long)i * G + c; if (L >= nwg) return false;
        int wgid = (int)L; { const int q = nwg / NXCD, r = nwg % NXCD, xcd = wgid % NXCD, off = wgid / NXCD; wgid = (xcd < r ? xcd * (q + 1) : r * (q + 1) + (xcd - r) * q) + off; }
        const int nig = WGM * nN, gid = wgid / nig, fm = gid * WGM, gsz = (nM - fm) < WGM ? (nM - fm) : WGM;
        u.pm = fm + ((wgid % nig) % gsz); u.pn = (wgid % nig) / gsz; u.pb = u.pn; return true;
    }
};
struct MoeOrder {
    static constexpr bool VARK = false;
    int t0, nT, nN, G, c; int tb[7];
    DI bool next(int i, Unit& u) const {
        const int nwg = nT * nN; const long L = (long)i * G + c; if (L >= nwg) return false;
        int w = (int)L; { const int q = nwg / NXCD, r = nwg % NXCD, xcd = w % NXCD, off = w / NXCD; w = (xcd < r ? xcd * (q + 1) : r * (q + 1) + (xcd - r) * q) + off; }
        const int nig = WGM * nN, gid = w / nig, fm = gid * WGM, gsz = (nT - fm) < WGM ? (nT - fm) : WGM;
        u.pm = t0 + fm + ((w % nig) % gsz); u.pn = (w % nig) / gsz;
        int e = 0;
#pragma unroll
        for (int x = 0; x < 7; ++x) e += (u.pm >= tb[x]) ? 1 : 0;
        u.pb = e * nN + u.pn; return true;
    }
};

struct UpOrder {
    static constexpr bool VARK = true;
    int G, c;
    DI bool next(int i, Unit& u) const {
        const long L = (long)i * G + c; if (L >= 1008) return false;
        const int xcd = (int)L % NXCD, off = (int)L / NXCD;
        if (off < 54) { const int w = 54 * xcd + off, gid = w / 24, r = w % 24; u.pm = 8 * gid + (r & 7); u.pn = r >> 3; u.kofs = 0; u.nt = 4; }
        else { const int w = 72 * xcd + (off - 54), gid = w >> 5, r = w & 31; u.pm = 8 * gid + (r & 7); u.pn = 3 + (r >> 3); u.kofs = 256; u.nt = 2; }
        u.pb = u.pn; return true;
    }
};

DI unsigned cvt_pk_bf16(float lo, float hi) { unsigned r; asm volatile("v_cvt_pk_bf16_f32 %0, %1, %2" : "=v"(r) : "v"(lo), "v"(hi)); return r; }

struct EpiBf16 {
    static constexpr bool PERM = true;
    GAS bf16_t* O; int ldc; float oscale;
    DI void operator()(const f32x4 (&acc)[2][2][4][2], const Unit& u, int wr, int wc, int fr, int fq) const {
        const int row0 = u.pm * BM + wr * 64 + fr, col0 = u.pn * BM + wc * 32 + 8 * fq;
#pragma unroll
        for (int ai = 0; ai < 2; ++ai)
#pragma unroll
            for (int m = 0; m < 4; ++m) { auto rowp = O + (size_t)(row0 + ai * HALF + m * 16) * ldc + col0;
#pragma unroll
                for (int bj = 0; bj < 2; ++bj) { const f32x4 v0 = acc[ai][bj][m][0] * oscale, v1 = acc[ai][bj][m][1] * oscale;
                    u32x4 w; w.x = cvt_pk_bf16(v0[0], v0[1]); w.y = cvt_pk_bf16(v0[2], v0[3]); w.z = cvt_pk_bf16(v1[0], v1[1]); w.w = cvt_pk_bf16(v1[2], v1[3]);
                    *(GAS u32x4*)(rowp + bj * HALF) = w; } }
    }
};
template <bool OUT8> struct EpiSwigluT {
    static constexpr bool PERM = true;
    GAS bf16_t* O; int ldc; int tile0; float oscale;
    DI void operator()(const f32x4 (&acc)[2][2][4][2], const Unit& u, int wr, int wc, int fr, int fq) const {
        const int row0 = (u.pm - tile0) * BM + wr * 64 + fr, col0 = u.pn * HALF + wc * 32 + 8 * fq;
#pragma unroll
        for (int ai = 0; ai < 2; ++ai)
#pragma unroll
            for (int m = 0; m < 4; ++m) { auto rowp = O + (size_t)(row0 + ai * HALF + m * 16) * ldc + col0;
                float o[8];
#pragma unroll
                for (int n = 0; n < 2; ++n)
#pragma unroll
                    for (int j = 0; j < 4; ++j) { const float a = acc[ai][0][m][n][j] * oscale, b = acc[ai][1][m][n][j] * oscale; o[n * 4 + j] = a * __builtin_amdgcn_rcpf(1.0f + __builtin_amdgcn_exp2f(-1.4426950408889634f * a)) * b; }
                if constexpr (OUT8) { int w0 = __builtin_amdgcn_cvt_pk_fp8_f32(o[0] * G8_SCALE, o[1] * G8_SCALE, 0, false); w0 = __builtin_amdgcn_cvt_pk_fp8_f32(o[2] * G8_SCALE, o[3] * G8_SCALE, w0, true);
                    int w1 = __builtin_amdgcn_cvt_pk_fp8_f32(o[4] * G8_SCALE, o[5] * G8_SCALE, 0, false); w1 = __builtin_amdgcn_cvt_pk_fp8_f32(o[6] * G8_SCALE, o[7] * G8_SCALE, w1, true);
                    u32x2 w; w.x = (unsigned)w0; w.y = (unsigned)w1; *(GAS u32x2*)((GAS unsigned char*)O + (size_t)(row0 + ai * HALF + m * 16) * ldc + col0) = w; }
                else { u32x4 w; w.x = cvt_pk_bf16(o[0], o[1]); w.y = cvt_pk_bf16(o[2], o[3]); w.z = cvt_pk_bf16(o[4], o[5]); w.w = cvt_pk_bf16(o[6], o[7]);
                    *(GAS u32x4*)rowp = w; } }
    }
};
typedef EpiSwigluT<false> EpiSwiglu;
typedef EpiSwigluT<true> EpiSwiglu8;
template <bool BASE32> struct EpiResidT {
    static constexpr bool PERM = false;
    const GAS void* base_lat; const GAS void* base_ctx; GAS bf16_t* out_lat; GAS bf16_t* out_ctx; const GAS float* modl; int goff;
    DI void operator()(const f32x4 (&acc)[2][2][4][2], const Unit& u, int wr, int wc, int fr, int fq) const {
        const int trow = u.pm * BM; const bool lat = trow < NLAT; const int midx = lat ? (trow >> 11) : 16;
        const size_t rbase = lat ? (size_t)trow * D : (size_t)(trow - NLAT) * D;
        auto base = lat ? base_lat : base_ctx; auto out = (lat ? out_lat : out_ctx) + rbase;
        auto gate = modl + (size_t)midx * 6144 + goff;
        const int col0 = u.pn * BM + wc * 32 + 4 * fq, r0 = wr * 64 + fr;
        f32x4 gv[2][2];
#pragma unroll
        for (int bj = 0; bj < 2; ++bj)
#pragma unroll
            for (int n = 0; n < 2; ++n) gv[bj][n] = *(const GAS f32x4*)(gate + col0 + bj * HALF + n * 16);
#pragma unroll
        for (int ai = 0; ai < 2; ++ai)
#pragma unroll
            for (int m = 0; m < 4; ++m) { const size_t off = (size_t)(r0 + ai * HALF + m * 16) * D + col0;
#pragma unroll
                for (int bj = 0; bj < 2; ++bj)
#pragma unroll
                    for (int n = 0; n < 2; ++n) { f32x4 bs;
                        if constexpr (BASE32) bs = *(const GAS f32x4*)((const GAS float*)base + rbase + off + bj * HALF + n * 16);
                        else { const u32x2 bw = *(const GAS u32x2*)((const GAS bf16_t*)base + rbase + off + bj * HALF + n * 16); bs = (f32x4){lo_f(bw.x), hi_f(bw.x), lo_f(bw.y), hi_f(bw.y)}; }
                        const f32x4 o = bs + gv[bj][n] * acc[ai][bj][m][n];
                        u32x2 w; w.x = cvt_pk_bf16(o[0], o[1]); w.y = cvt_pk_bf16(o[2], o[3]); *(GAS u32x2*)(out + off + bj * HALF + n * 16) = w; }
                asm volatile("" ::: "memory"); }
    }
};

template <class Epi, class Sched, bool GATHER, bool FP8 = false>
DI void gemm_phase(LAS unsigned char* lds, const Gemm g, const Sched& S, const Epi& E, const int tid) {
    const int wid = __builtin_amdgcn_readfirstlane(tid >> 6), lane = tid & 63, wr = wid >> 2, wc = wid & 3, fr = lane & 15, fq = lane >> 4;
    const int Kb = FP8 ? g.K : 2 * g.K, ldab = FP8 ? g.lda : 2 * g.lda, nt = Kb / 128;
    int R0, C0; stage_rc(tid * 16, R0, C0);
    const int Rb = Epi::PERM ? ((R0 & ~31) + perm32(R0 & 31)) : R0;
    const unsigned voffB = (unsigned)(Rb * Kb + 2 * C0), voffA = (unsigned)(R0 * ldab + 2 * C0);
    const size_t kstep = (size_t)(BK * 2);
    const size_t hstepB = (size_t)HALF * Kb, tstepB = 2 * hstepB, r64B = (size_t)64 * Kb;
    const size_t hstepA = (size_t)HALF * ldab, tstepA = 2 * hstepA, r64A = (size_t)64 * ldab;
    const unsigned ldsw = (unsigned)wid * 1024u;
    const int aoff = lds_byte(wr * 64 + fr, fq * 8), boff = lds_byte(wc * 32 + fr, fq * 8);
    const __amdgpu_buffer_rsrc_t rsA = __builtin_amdgcn_make_buffer_rsrc((GAS void*)g.A, 0, 0x7ffffffc, 0x00020000), rsB = __builtin_amdgcn_make_buffer_rsrc((GAS void*)g.Bt, 0, 0x7ffffffc, 0x00020000);
#define PG8_SA(b, h) (((b) * 2 + (h)) * HTB)
#define PG8_SB(b, h) ((4 + (b) * 2 + (h)) * HTB)
#define PG8_BLDS(rs, vo, so, loff) __builtin_amdgcn_raw_ptr_buffer_load_lds((rs), (LAS void*)(lds + (loff)), 16, (int)(vo), __builtin_amdgcn_readfirstlane((int)(so)), 0, 0)
#define PG8_STAGE_B(bufoff, gbase) do { PG8_BLDS(rsB, voffB, (gbase), (bufoff) + ldsw); PG8_BLDS(rsB, voffB, (gbase) + r64B, (bufoff) + ldsw + 8192); } while (0)
#define PG8_STAGE_A(bufoff, ubase, kb, vo) do { if constexpr (GATHER) { PG8_BLDS(rsA, (vo)[0], (kb), (bufoff) + ldsw); PG8_BLDS(rsA, (vo)[1], (kb), (bufoff) + ldsw + 8192); } \
        else { PG8_BLDS(rsA, voffA, (ubase) + (kb), (bufoff) + ldsw); PG8_BLDS(rsA, voffA, (ubase) + (kb) + r64A, (bufoff) + ldsw + 8192); } } while (0)
#define PG8_GOFF(u, h, i) ((unsigned)(g.rowidx[(u).pm * BM + (h) * HALF + R0 + (i) * 64] * ldab + 2 * C0))
#define PG8_LD8(p) __builtin_shufflevector(*(const LAS i32x4*)(p), *(const LAS i32x4*)((p) + 1024), 0, 1, 2, 3, 4, 5, 6, 7)
#define PG8_LDA(dst, b, h) do { if constexpr (FP8) { _Pragma("unroll") for (int m = 0; m < 4; ++m) dst##8[m] = PG8_LD8(lds + PG8_SA(b, h) + aoff + m * 2048); } \
        else { _Pragma("unroll") for (int m = 0; m < 4; ++m) _Pragma("unroll") for (int k = 0; k < 2; ++k) dst[m][k] = *(const LAS bf16x8*)(lds + PG8_SA(b, h) + aoff + m * 2048 + k * 1024); } } while (0)
#define PG8_LDB(dst, b, h) do { if constexpr (FP8) { _Pragma("unroll") for (int n = 0; n < 2; ++n) dst##8[n] = PG8_LD8(lds + PG8_SB(b, h) + boff + n * 2048); } \
        else { _Pragma("unroll") for (int n = 0; n < 2; ++n) _Pragma("unroll") for (int k = 0; k < 2; ++k) dst[n][k] = *(const LAS bf16x8*)(lds + PG8_SB(b, h) + boff + n * 2048 + k * 1024); } } while (0)
#define PG8_MMA(ai, bj, At, Bt) do { __builtin_amdgcn_s_setprio(1); if constexpr (FP8) { _Pragma("unroll") for (int m = 0; m < 4; ++m) _Pragma("unroll") for (int n = 0; n < 2; ++n) \
        asm volatile("v_mfma_f32_16x16x128_f8f6f4 %0, %1, %2, %0" : "+v"(acc[ai][bj][m][n]) : "v"(Bt##8[n]), "v"(At##8[m])); }     \
        else { _Pragma("unroll") for (int m = 0; m < 4; ++m) _Pragma("unroll") for (int n = 0; n < 2; ++n) _Pragma("unroll") for (int k = 0; k < 2; ++k) \
        acc[ai][bj][m][n] = __builtin_amdgcn_mfma_f32_16x16x32_bf16(Bt[n][k], At[m][k], acc[ai][bj][m][n], 0, 0, 0); } __builtin_amdgcn_s_setprio(0); } while (0)
#define PG8_SSQ(h) do { if constexpr (Sched::VARK) { _Pragma("unroll") for (int m = 0; m < 4; ++m) _Pragma("unroll") for (int k = 0; k < 2; ++k) { const u32x4 w_ = __builtin_bit_cast(u32x4, At[m][k]); \
        _Pragma("unroll") for (int e = 0; e < 4; ++e) { const bf16x2_t p_ = __builtin_bit_cast(bf16x2_t, w_[e]); ssq[h][m] = __builtin_amdgcn_fdot2_f32_bf16(p_, p_, ssq[h][m], false); } } } } while (0)
#define PG8_WAIT_V(n) asm volatile("s_waitcnt vmcnt(" #n ")" ::: "memory")
#define PG8_WAIT_L(n) asm volatile("s_waitcnt lgkmcnt(" #n ")" ::: "memory")
#define PG8_BAR __builtin_amdgcn_s_barrier()
#define PG8_SCHED __builtin_amdgcn_sched_barrier(0)
    Unit cur, nxt; int ui = 0;
    if (!S.next(0, cur)) return;
    f32x4 acc[2][2][4][2];
#pragma unroll
    for (int a = 0; a < 2; ++a)
#pragma unroll
        for (int b = 0; b < 2; ++b)
#pragma unroll
            for (int m = 0; m < 4; ++m)
#pragma unroll
                for (int n = 0; n < 2; ++n) acc[a][b][m][n] = (f32x4){0.f, 0.f, 0.f, 0.f};
    bf16x8 At[4][2], B0[2][2], B1[2][2]; i32x8 At8[4], B08[2], B18[2];
    float ssq[2][4] = {{0.f, 0.f, 0.f, 0.f}, {0.f, 0.f, 0.f, 0.f}};
    unsigned va0[2] = {0u, 0u}, va1[2] = {0u, 0u};
    if constexpr (GATHER) { va0[0] = PG8_GOFF(cur, 0, 0); va0[1] = PG8_GOFF(cur, 0, 1); va1[0] = PG8_GOFF(cur, 1, 0); va1[1] = PG8_GOFF(cur, 1, 1); }
    unsigned cA = (unsigned)((size_t)cur.pm * tstepA), cB = (unsigned)((size_t)cur.pb * tstepB);
    if constexpr (Sched::VARK) { cA += 2u * (unsigned)cur.kofs; cB += 2u * (unsigned)cur.kofs; }
    PG8_STAGE_B(PG8_SB(0, 0), cB); PG8_STAGE_A(PG8_SA(0, 0), cA, 0, va0); PG8_STAGE_B(PG8_SB(0, 1), cB + hstepB); PG8_STAGE_A(PG8_SA(0, 1), cA + hstepA, 0, va1);
    if (wr == 1) PG8_BAR;
    PG8_WAIT_V(4); PG8_BAR;
    PG8_STAGE_B(PG8_SB(1, 0), cB + kstep); PG8_STAGE_A(PG8_SA(1, 0), cA, kstep, va0); PG8_STAGE_B(PG8_SB(1, 1), cB + hstepB + kstep);
    PG8_WAIT_V(6); PG8_BAR;
    for (;;) {
        const bool has_next = S.next(ui + 1, nxt);
        unsigned nA = has_next ? (unsigned)((size_t)nxt.pm * tstepA) : cA, nB = has_next ? (unsigned)((size_t)nxt.pb * tstepB) : cB;
        if constexpr (Sched::VARK) { if (has_next) { nA += 2u * (unsigned)nxt.kofs; nB += 2u * (unsigned)nxt.kofs; } }
        const int ntc = Sched::VARK ? cur.nt : nt;
        int vi[4] = {0, 0, 0, 0};
        if constexpr (GATHER) { if (has_next) { vi[0] = g.rowidx[nxt.pm * BM + R0]; vi[1] = g.rowidx[nxt.pm * BM + R0 + 64]; vi[2] = g.rowidx[nxt.pm * BM + HALF + R0]; vi[3] = g.rowidx[nxt.pm * BM + HALF + R0 + 64]; } }
#pragma unroll 1
        for (int t = 0; t < ntc; t += 2) {
            const bool last = (t == ntc - 2);
            const size_t k1 = (size_t)(t + 1) * kstep;
            const size_t k2 = last ? 0 : (size_t)(t + 2) * kstep, k3 = k2 + kstep;
            const unsigned a2 = last ? nA : cA; const unsigned b2 = last ? nB : cB + (unsigned)((t + 2) * kstep); const unsigned b3 = b2 + (unsigned)kstep;
            if constexpr (GATHER) { if (last && has_next) { va0[0] = (unsigned)(vi[0] * ldab + 2 * C0); va0[1] = (unsigned)(vi[1] * ldab + 2 * C0); } }
            PG8_LDB(B0, 0, 0); PG8_SCHED; PG8_LDA(At, 0, 0); PG8_STAGE_A(PG8_SA(1, 1), cA + hstepA, k1, va1);
            if constexpr (GATHER) { if (last && has_next) { va1[0] = (unsigned)(vi[2] * ldab + 2 * C0); va1[1] = (unsigned)(vi[3] * ldab + 2 * C0); } }
            PG8_WAIT_L(8); PG8_BAR; PG8_WAIT_L(0); PG8_MMA(0, 0, At, B0); PG8_SSQ(0); PG8_BAR; PG8_SCHED;
            PG8_LDB(B1, 0, 1); PG8_STAGE_B(PG8_SB(0, 0), b2);
            PG8_BAR; PG8_WAIT_L(0); PG8_MMA(0, 1, At, B1); PG8_BAR;
            PG8_LDA(At, 0, 1); PG8_STAGE_A(PG8_SA(0, 0), a2, k2, va0);
            PG8_BAR; PG8_WAIT_L(0); PG8_MMA(1, 0, At, B0); PG8_SSQ(1); PG8_BAR; PG8_SCHED;
            PG8_STAGE_B(PG8_SB(0, 1), b2 + hstepB);
            PG8_WAIT_V(6); PG8_BAR; PG8_MMA(1, 1, At, B1); PG8_BAR;
            PG8_LDB(B0, 1, 0); PG8_SCHED; PG8_LDA(At, 1, 0); PG8_STAGE_A(PG8_SA(0, 1), a2 + hstepA, k2, va1);
            PG8_WAIT_L(8); PG8_BAR; PG8_WAIT_L(0); PG8_MMA(0, 0, At, B0); PG8_SSQ(0); PG8_BAR; PG8_SCHED;
            PG8_LDB(B1, 1, 1); PG8_STAGE_B(PG8_SB(1, 0), b3);
            PG8_BAR; PG8_WAIT_L(0); PG8_MMA(0, 1, At, B1); PG8_BAR;
            PG8_LDA(At, 1, 1); PG8_STAGE_A(PG8_SA(1, 0), a2, k3, va0);
            PG8_BAR; PG8_WAIT_L(0); PG8_MMA(1, 0, At, B0); PG8_SSQ(1); PG8_BAR; PG8_SCHED;
            PG8_STAGE_B(PG8_SB(1, 1), b3 + hstepB);
            PG8_WAIT_V(6); PG8_BAR; PG8_MMA(1, 1, At, B1); PG8_BAR;
        }
        if constexpr (FP8) asm volatile("s_nop 15\n\ts_nop 7" : "+v"(acc[1][1][0][0]), "+v"(acc[1][1][0][1]), "+v"(acc[1][1][1][0]), "+v"(acc[1][1][1][1]), "+v"(acc[1][1][2][0]), "+v"(acc[1][1][2][1]), "+v"(acc[1][1][3][0]), "+v"(acc[1][1][3][1]));
        if constexpr (Sched::VARK) {
#pragma unroll
            for (int a = 0; a < 2; ++a)
#pragma unroll
                for (int m = 0; m < 4; ++m) { float t_ = ssq[a][m]; t_ += __shfl_xor(t_, 16); t_ += __shfl_xor(t_, 32); const float r_ = 1.0f / sqrtf(t_ / (float)(64 * ntc) + EPS); ssq[a][m] = 0.f;
#pragma unroll
                    for (int b = 0; b < 2; ++b)
#pragma unroll
                        for (int n = 0; n < 2; ++n) acc[a][b][m][n] *= r_; }
        }
        E(acc, cur, wr, wc, fr, fq);
        if (!has_next) break;
#pragma unroll
        for (int a = 0; a < 2; ++a)
#pragma unroll
            for (int b = 0; b < 2; ++b)
#pragma unroll
                for (int m = 0; m < 4; ++m)
#pragma unroll
                    for (int n = 0; n < 2; ++n) acc[a][b][m][n] = (f32x4){0.f, 0.f, 0.f, 0.f};
        cur = nxt; cA = nA; cB = nB; ++ui;
    }
    PG8_WAIT_V(0);
    if (wr == 0) PG8_BAR;
    PG8_BAR;
#undef PG8_SA
#undef PG8_SB
#undef PG8_BLDS
#undef PG8_STAGE_B
#undef PG8_STAGE_A
#undef PG8_GOFF
#undef PG8_LD8
#undef PG8_LDA
#undef PG8_LDB
#undef PG8_MMA
#undef PG8_WAIT_V
#undef PG8_SSQ
#undef PG8_WAIT_L
#undef PG8_BAR
#undef PG8_SCHED
}
}

struct TJob { const float* src; const float* kgain; bf16_t* dst; int K, N, src_col0, ncols, dst_row0, dst_k0, dst_ld, grp, grp_stride, nbatch, src_bstride, dst_bstride; float scale; int item0, fp8, pad; };
constexpr int NJOBS = 28, NJOBS_PRO = 25;
struct Params {
    const float* in[30];
    float* out; unsigned char* ws;
    int ph_lo, ph_hi, n_items_pro, n_items_moe;
    TJob jobs[NJOBS];
};
enum { I_X = 0, I_C, I_CTX, I_CCTX, I_ADAW, I_ADAB, I_N1G, I_N2G, I_WIN, I_WOUT, I_GATEB, I_MNG, I_CQG, I_CKVG, I_WUQ, I_WUKV, I_QG, I_KG, I_LNG, I_LNB, I_WS, I_BS,
       I_FW1, I_FW3, I_FW2, I_RW, I_RB, I_MW1, I_MW3, I_MW2 };

DI void tr_item(const TJob& J, int r, LAS float* scr, int lane) {
    const int nkb = J.K / 64, nnb = (J.ncols + 31) / 32, per = nkb * nnb;
    const int bt = r / per; r -= bt * per;
    const int kb = r / nnb, nb = r % nnb, k0 = 64 * kb, n0 = 32 * nb;
    auto W = J.src + (size_t)bt * J.src_bstride;
    const int n4 = n0 + 4 * (lane & 7); const bool nok = n4 < J.ncols;
    f32x4 wv[8];
#pragma unroll
    for (int i = 0; i < 8; ++i) { const int kk = 8 * i + (lane >> 3); wv[i] = nok ? *(const GAS f32x4*)(W + (size_t)(k0 + kk) * J.N + J.src_col0 + n4) : (f32x4){0.f, 0.f, 0.f, 0.f}; }
#pragma unroll
    for (int i = 0; i < 8; ++i) { const int kk = 8 * i + (lane >> 3); float sc_ = J.scale; if (J.kgain) sc_ *= J.kgain[k0 + kk];
        auto d = scr + kk * 33 + 4 * (lane & 7); d[0] = wv[i][0] * sc_; d[1] = wv[i][1] * sc_; d[2] = wv[i][2] * sc_; d[3] = wv[i][3] * sc_; }
    asm volatile("s_waitcnt lgkmcnt(0)" ::: "memory");
    const int c = lane & 7;
#pragma unroll
    for (int j = 0; j < 4; ++j) { const int nn = (lane >> 3) + 8 * j, ncol = n0 + nn;
        if (ncol < J.ncols) { auto s = scr + (8 * c) * 33 + nn;
            const int drow = J.dst_row0 + (ncol / J.grp) * J.grp_stride + (ncol % J.grp);
            const size_t doff = (size_t)bt * J.dst_bstride + (size_t)drow * J.dst_ld + J.dst_k0 + k0 + 8 * c;
            if (J.fp8) { int w0 = __builtin_amdgcn_cvt_pk_fp8_f32(s[0 * 33], s[1 * 33], 0, false); w0 = __builtin_amdgcn_cvt_pk_fp8_f32(s[2 * 33], s[3 * 33], w0, true);
                int w1 = __builtin_amdgcn_cvt_pk_fp8_f32(s[4 * 33], s[5 * 33], 0, false); w1 = __builtin_amdgcn_cvt_pk_fp8_f32(s[6 * 33], s[7 * 33], w1, true);
                u32x2 o; o.x = (unsigned)w0; o.y = (unsigned)w1; *(GAS u32x2*)((GAS unsigned char*)J.dst + doff) = o; }
            else { u32x4 o; o.x = pk2(s[0 * 33], s[1 * 33]); o.y = pk2(s[2 * 33], s[3 * 33]); o.z = pk2(s[4 * 33], s[5 * 33]); o.w = pk2(s[6 * 33], s[7 * 33]);
                *(GAS u32x4*)(J.dst + doff) = o; } } }
    asm volatile("s_waitcnt lgkmcnt(0)" ::: "memory");
}
DI void run_jobs(const Params& P, int j0, int j1, int item_lo, int nitems, LAS unsigned char* lds, int gw, int NGW, int wave, int lane) {
    LAS float* scr = (LAS float*)(lds + wave * 16384);
    for (int it = item_lo + gw; it < nitems; it += NGW) {
        int j = j0;
        while (j + 1 < j1 && it >= P.jobs[j + 1].item0) ++j;
        tr_item(P.jobs[j], it - P.jobs[j].item0, scr, lane);
    }
}

template <bool ROUTE, bool OUT8 = false, bool IN16 = false>
DI void phase_norm(const Params& P, GAS unsigned char* wsb, int l, int which, int nrows, const GAS void* xlat, const GAS void* xctx, GAS bf16_t* XN, LAS unsigned char* lds, int tid, int wave, int lane) {
    const GAS float* modl = (const GAS float*)(wsb + WS_MOD) + (size_t)l * 17 * 6144;
    auto gvec = P.in[opq_i(which ? I_N2G : I_N1G)] + l * D;
    const int per_blk = nrows / 256, per_wave = per_blk / 8;
    f32x4 gg[4], aa[4], ss[4]; int cur_midx = -1;
#pragma unroll
    for (int j = 0; j < 4; ++j) gg[j] = ((const GAS f32x4*)gvec)[64 * j + lane];
    LAS float* rw = (LAS float*)lds;
    LAS unsigned* cnt = (LAS unsigned*)(lds + 32768);
    if (ROUTE) {
        auto rwg = P.in[opq_i(I_RW)];
        for (int i = tid; i < 8192; i += 512) rw[i] = rwg[i];
        if (tid < 8) cnt[tid] = 0u;
        __syncthreads();
    }
    const int rowb = blockIdx.x * per_blk + wave * per_wave;
    f32x4 qf[3][4]; u32x2 qh[3][4];
#define NORM_LOAD(slot, ri) do { const int r_ = rowb + (ri); const bool lat_ = r_ < NLAT; const size_t xo_ = lat_ ? (size_t)r_ * D : (size_t)(r_ - NLAT) * D; auto xp_ = lat_ ? xlat : xctx; \
        _Pragma("unroll") for (int j = 0; j < 4; ++j) { if constexpr (IN16) qh[slot][j] = ((const GAS u32x2*)((const GAS bf16_t*)xp_ + xo_))[64 * j + lane]; else qf[slot][j] = ((const GAS f32x4*)((const GAS float*)xp_ + xo_))[64 * j + lane]; } } while (0)
    NORM_LOAD(0, 0); if (per_wave > 1) NORM_LOAD(1, 1);
    for (int i3 = 0; i3 < per_wave; i3 += 3) {
#pragma unroll
      for (int sl = 0; sl < 3; ++sl) { const int i = i3 + sl; if (i < per_wave) {
        const int row = rowb + i;
        const bool lat = row < NLAT; const int midx = lat ? (row >> 11) : 16;
        if (i + 2 < per_wave) NORM_LOAD((sl + 2) % 3, i + 2);
        if (midx != cur_midx) { cur_midx = midx; auto mp = modl + (size_t)midx * 6144 + (which ? 3 * D : 0);
#pragma unroll
            for (int j = 0; j < 4; ++j) { ss[j] = ((const GAS f32x4*)mp)[64 * j + lane]; const f32x4 sc = ((const GAS f32x4*)(mp + D))[64 * j + lane]; aa[j] = gg[j] * (sc + 1.0f); } }
        f32x4 v[4]; float s2 = 0.f;
#pragma unroll
        for (int j = 0; j < 4; ++j) { if constexpr (IN16) { const u32x2 xw = qh[sl][j]; v[j] = (f32x4){lo_f(xw.x), hi_f(xw.x), lo_f(xw.y), hi_f(xw.y)}; } else v[j] = qf[sl][j];
            s2 += (v[j].x * v[j].x + v[j].y * v[j].y) + (v[j].z * v[j].z + v[j].w * v[j].w); }
        const float r = 1.0f / sqrtf(wave_sum(s2) * (1.0f / D) + EPS);
        GAS u32x2* o8 = (GAS u32x2*)(XN + (size_t)row * D);
        float lg[8];
        if (ROUTE) {
#pragma unroll
            for (int e = 0; e < 8; ++e) lg[e] = 0.f; }
#pragma unroll
        for (int j = 0; j < 4; ++j) { const f32x4 y = v[j] * r * aa[j] + ss[j];
            if constexpr (OUT8) { int w8 = __builtin_amdgcn_cvt_pk_fp8_f32(y.x * H8_SCALE, y.y * H8_SCALE, 0, false); w8 = __builtin_amdgcn_cvt_pk_fp8_f32(y.z * H8_SCALE, y.w * H8_SCALE, w8, true);
                ((GAS unsigned*)((GAS unsigned char*)XN + (size_t)row * D))[64 * j + lane] = (unsigned)w8; }
            else { u32x2 w; w.x = pk2(y.x, y.y); w.y = pk2(y.z, y.w); o8[64 * j + lane] = w; }
            if (ROUTE) { const LAS f32x4* rp = (const LAS f32x4*)(rw + (size_t)(4 * (64 * j + lane)) * 8);
#pragma unroll
                for (int c = 0; c < 4; ++c) { const f32x4 w0 = rp[2 * c], w1 = rp[2 * c + 1]; const float yc = y[c];
                    lg[0] += yc * w0.x; lg[1] += yc * w0.y; lg[2] += yc * w0.z; lg[3] += yc * w0.w; lg[4] += yc * w1.x; lg[5] += yc * w1.y; lg[6] += yc * w1.z; lg[7] += yc * w1.w; } } }
        if (ROUTE) {
            auto rb = P.in[opq_i(I_RB)];
#pragma unroll
            for (int e = 0; e < 8; ++e) lg[e] = wave_sum(lg[e]) + rb[e];
            int i0 = 0; float l0 = lg[0];
#pragma unroll
            for (int e = 1; e < 8; ++e) if (lg[e] > l0) { l0 = lg[e]; i0 = e; }
            int i1 = -1; float l1 = -3.0e38f;
#pragma unroll
            for (int e = 0; e < 8; ++e) if (e != i0 && lg[e] > l1) { l1 = lg[e]; i1 = e; }
            const float g0 = 1.0f / (1.0f + __expf(l1 - l0)), g1 = 1.0f - g0;
            if (lane == 0) { GAS int* ti = (GAS int*)(wsb + WS_TOPI); GAS float* tg = (GAS float*)(wsb + WS_TOPG);
                ti[2 * row] = i0; ti[2 * row + 1] = i1; tg[2 * row] = g0; tg[2 * row + 1] = g1;
                atomicAdd((unsigned*)&cnt[i0], 1u); atomicAdd((unsigned*)&cnt[i1], 1u); }
        }
      } }
    }
#undef NORM_LOAD
    if (ROUTE) { __syncthreads(); if (tid < 8) ((GAS unsigned*)wsb + CW_BCNT)[blockIdx.x * 8 + tid] = cnt[tid]; }
}

DI void phase_prep(const Params& P, GAS unsigned char* wsb, int l, int gw, int NGW, int lane) {
    const GAS bf16_t* Z = (const GAS bf16_t*)(wsb + WS_Z); GAS bf16_t* VLN = (GAS bf16_t*)(wsb + WS_VLN);
    const f32x4 lg = ((const GAS f32x4*)(P.in[opq_i(I_LNG)] + l * 256))[lane], lb = ((const GAS f32x4*)(P.in[opq_i(I_LNB)] + l * 256))[lane];
    const int nrows = l == 0 ? NTOK : NLAT;
    u32x2 gn = {0u, 0u};
    if (gw < nrows) gn = *(const GAS u32x2*)(Z + (size_t)gw * ZW + ZGV + 4 * lane);
    for (int row = gw; row < nrows; row += NGW) {
        const u32x2 g = gn;
        if (row + NGW < nrows) gn = *(const GAS u32x2*)(Z + (size_t)(row + NGW) * ZW + ZGV + 4 * lane);
        const float a0 = gelu_tanh(lo_f(g.x)), a1 = gelu_tanh(hi_f(g.x)), a2 = gelu_tanh(lo_f(g.y)), a3 = gelu_tanh(hi_f(g.y));
        const float mu = wave_sum((a0 + a1) + (a2 + a3)) * (1.0f / 256.0f);
        const float d0 = a0 - mu, d1 = a1 - mu, d2 = a2 - mu, d3 = a3 - mu;
        const float rs = 1.0f / sqrtf(wave_sum((d0 * d0 + d1 * d1) + (d2 * d2 + d3 * d3)) * (1.0f / 256.0f) + EPS);
        u32x2 o; o.x = pk2(d0 * rs * lg.x + lb.x, d1 * rs * lg.y + lb.y); o.y = pk2(d2 * rs * lg.z + lb.z, d3 * rs * lg.w + lb.w);
        *(GAS u32x2*)(VLN + (size_t)row * 256 + 4 * lane) = o;
    }
}

DI void phase_qk(const Params& P, GAS unsigned char* wsb, int l, int gw, int NGW, int lane) {
    const GAS bf16_t* Z = (const GAS bf16_t*)(wsb + WS_Z); GAS bf16_t* QKV = (GAS bf16_t*)(wsb + WS_QKV); GAS bf16_t* KF = (GAS bf16_t*)(wsb + WS_KF);
    const int hd = lane >> 3, sub = lane & 7;
    auto qg = P.in[opq_i(I_QG)] + l * 96; auto kg = P.in[opq_i(I_KG)] + l * 96;
    float qgn[8], kgn[8], qgr[4], kgr[4];
#pragma unroll
    for (int j = 0; j < 8; ++j) { qgn[j] = qg[sub * 8 + j]; kgn[j] = kg[sub * 8 + j]; }
    qgr[0] = qg[64 + 2 * sub]; qgr[1] = qg[64 + 2 * sub + 1]; qgr[2] = qg[80 + 2 * sub]; qgr[3] = qg[80 + 2 * sub + 1];
    kgr[0] = kg[64 + 2 * sub]; kgr[1] = kg[64 + 2 * sub + 1]; kgr[2] = kg[80 + 2 * sub]; kgr[3] = kg[80 + 2 * sub + 1];
    float kgm = 0.f;
    for (int e = 0; e < 96; ++e) kgm = fmaxf(kgm, fabsf(kg[e]));
    const float kbound = 9.797958971f * kgm * 1.02f;
    const int i0 = 2 * sub, i1 = 2 * sub + 1;
    const float inv0 = __powf(10000.0f, -(float)(i0 & 7) * 0.125f), inv1 = __powf(10000.0f, -(float)(i1 & 7) * 0.125f);
#define QK_LOAD(row_, qa_, q0_, q1_, ka_, k0_, k1_) do { auto qr_ = QKV + (size_t)(row_) * UPN; auto zr_ = Z + (size_t)(row_) * ZW + ZKR; \
        qa_ = *(const GAS u32x4*)(qr_ + hd * 96 + sub * 8); q0_ = *(const GAS unsigned*)(qr_ + hd * 96 + 64 + 2 * sub); q1_ = *(const GAS unsigned*)(qr_ + hd * 96 + 80 + 2 * sub); \
        ka_ = *(const GAS u32x4*)(qr_ + 768 + hd * 128 + sub * 8); k0_ = *(const GAS unsigned*)(zr_ + 2 * sub); k1_ = *(const GAS unsigned*)(zr_ + 16 + 2 * sub); } while (0)
    u32x4 cqa = {0u, 0u, 0u, 0u}, cka = {0u, 0u, 0u, 0u}; unsigned cq0 = 0u, cq1 = 0u, ck0 = 0u, ck1 = 0u;
    if (gw < NTOK) QK_LOAD(gw, cqa, cq0, cq1, cka, ck0, ck1);
    for (int row = gw; row < NTOK; row += NGW) {
        u32x4 nqa = cqa, nka = cka; unsigned nq0 = cq0, nq1 = cq1, nk0 = ck0, nk1 = ck1;
        if (row + NGW < NTOK) QK_LOAD(row + NGW, nqa, nq0, nq1, nka, nk0, nk1);
        const bool lat = row < NLAT;
        float c0 = 1.f, s0 = 0.f, c1 = 1.f, s1 = 0.f;
        if (lat) { const int s = row & (SEQ - 1); const float pr = (float)(s >> 6), pc = (float)(s & 63);
            const float a0 = (i0 < 8 ? pr : pc) * inv0, a1 = (i1 < 8 ? pr : pc) * inv1; s0 = __sinf(a0); c0 = __cosf(a0); s1 = __sinf(a1); c1 = __cosf(a1); }
        auto qr = QKV + (size_t)row * UPN + hd * 96;
        {
            const u32x4 a = cqa; const unsigned r0 = cq0, r1 = cq1;
            float x[8] = {lo_f(a.x), hi_f(a.x), lo_f(a.y), hi_f(a.y), lo_f(a.z), hi_f(a.z), lo_f(a.w), hi_f(a.w)};
            float t1a = lo_f(r0), t1b = hi_f(r0), t2a = lo_f(r1), t2b = hi_f(r1);
            float ssq = t1a * t1a + t1b * t1b + t2a * t2a + t2b * t2b;
#pragma unroll
            for (int j = 0; j < 8; ++j) ssq += x[j] * x[j];
            ssq += __shfl_xor(ssq, 1); ssq += __shfl_xor(ssq, 2); ssq += __shfl_xor(ssq, 4);
            const float r = 1.0f / sqrtf(ssq * (1.0f / 96.0f) + EPS);
            if (l == 0 || lat) {
#pragma unroll
                for (int j = 0; j < 8; ++j) x[j] = x[j] * r * qgn[j] * QSCALE;
                t1a = t1a * r * qgr[0]; t1b = t1b * r * qgr[1]; t2a = t2a * r * qgr[2]; t2b = t2b * r * qgr[3];
                const float o1a = (t1a * c0 - t2a * s0) * QSCALE, o1b = (t1b * c1 - t2b * s1) * QSCALE, o2a = (t1a * s0 + t2a * c0) * QSCALE, o2b = (t1b * s1 + t2b * c1) * QSCALE;
                u32x4 w; w.x = pk2(x[0], x[1]); w.y = pk2(x[2], x[3]); w.z = pk2(x[4], x[5]); w.w = pk2(x[6], x[7]);
                *(GAS u32x4*)(qr + sub * 8) = w; *(GAS unsigned*)(qr + 64 + 2 * sub) = pk2(o1a, o1b); *(GAS unsigned*)(qr + 80 + 2 * sub) = pk2(o2a, o2b);
                float qq = (o1a * o1a + o1b * o1b) + (o2a * o2a + o2b * o2b);
#pragma unroll
                for (int j = 0; j < 8; ++j) qq += x[j] * x[j];
                qq += __shfl_xor(qq, 1); qq += __shfl_xor(qq, 2); qq += __shfl_xor(qq, 4);
                if (sub == 0) ((GAS float*)(wsb + WS_QM))[(size_t)row * 8 + hd] = sqrtf(qq) * kbound;
            }
        }
        {
            const u32x4 a = cka; const unsigned r0 = ck0, r1 = ck1;
            float x[8] = {lo_f(a.x), hi_f(a.x), lo_f(a.y), hi_f(a.y), lo_f(a.z), hi_f(a.z), lo_f(a.w), hi_f(a.w)};
            float t1a = lo_f(r0), t1b = hi_f(r0), t2a = lo_f(r1), t2b = hi_f(r1);
            float ssq = t1a * t1a + t1b * t1b + t2a * t2a + t2b * t2b;
#pragma unroll
            for (int j = 0; j < 8; ++j) ssq += x[j] * x[j];
            ssq += __shfl_xor(ssq, 1); ssq += __shfl_xor(ssq, 2); ssq += __shfl_xor(ssq, 4);
            const float r = 1.0f / sqrtf(ssq * (1.0f / 96.0f) + EPS);
#pragma unroll
            for (int j = 0; j < 8; ++j) x[j] = x[j] * r * kgn[j];
            t1a = t1a * r * kgr[0]; t1b = t1b * r * kgr[1]; t2a = t2a * r * kgr[2]; t2b = t2b * r * kgr[3];
            const float o1a = t1a * c0 - t2a * s0, o1b = t1b * c1 - t2b * s1, o2a = t1a * s0 + t2a * c0, o2b = t1b * s1 + t2b * c1;
            auto ko = KF + (size_t)row * 768 + hd * 96;
            u32x4 w; w.x = pk2(x[0], x[1]); w.y = pk2(x[2], x[3]); w.z = pk2(x[4], x[5]); w.w = pk2(x[6], x[7]);
            *(GAS u32x4*)(ko + sub * 8) = w; *(GAS unsigned*)(ko + 64 + 2 * sub) = pk2(o1a, o1b); *(GAS unsigned*)(ko + 80 + 2 * sub) = pk2(o2a, o2b);
        }
        cqa = nqa; cq0 = nq0; cq1 = nq1; cka = nka; ck0 = nk0; ck1 = nk1;
    }
#undef QK_LOAD
}

constexpr int AT_KBUF = 64 * 192, AT_VBUF = 64 * 128;
typedef short s16x4_t __attribute__((ext_vector_type(4)));
DI void phase_attn(const Params& P, GAS unsigned char* wsb, int l, LAS unsigned char* lds, const int tid) {
    const GAS bf16_t* QKV = (const GAS bf16_t*)(wsb + WS_QKV); const GAS bf16_t* KF = (const GAS bf16_t*)(wsb + WS_KF); GAS bf16_t* MIX = (GAS bf16_t*)(wsb + WS_XN);
    const int lane = tid & 63, wave = __builtin_amdgcn_readfirstlane(tid >> 6), fr = lane & 15, fq = lane >> 4;
    const int nunits = l == 0 ? 1152 : 1024, G = gridDim.x;
    const int vcu = (G % 8 == 0) ? (int)(blockIdx.x % 8) * (G / 8) + (int)(blockIdx.x / 8) : (int)blockIdx.x;
    const int kp_a = tid, kp_b = 512 + tid; const int krow_a = kp_a / 12, krow_b = kp_b / 12;
    const int kc_a = ((kp_a % 12) & 12) | (((kp_a % 12) & 3) ^ ((krow_a >> 1) & 3)), kc_b = ((kp_b % 12) & 12) | (((kp_b % 12) & 3) ^ ((krow_b >> 1) & 3));
    const int vrow = tid >> 3, vch = (tid & 7) ^ (2 * ((vrow >> 1) & 3));
    const int tq = (lane >> 2) & 3, tp = lane & 3, vsw = 2 * (fq & 1) + (tq >> 1);
    const int vtoff = 128 * (4 * fq + tq) + 8 * tp;
    auto const KB = lds; auto const VB = lds + 3 * AT_KBUF;
    const int koff = fr * 192 + 16 * (fq ^ ((fr >> 1) & 3));
    for (int u = vcu; u < nunits; u += G) {
        int b, hd, qrow0, nt; bool lat;
        if (u < 1024) { b = u >> 6; hd = (u >> 3) & 7; qrow0 = b * SEQ + (u & 7) * 256; nt = 36; lat = true; }
        else { const int uu = u - 1024; b = uu >> 3; hd = uu & 7; qrow0 = NLAT + b * CTXL; nt = 4; lat = false; }
#define AT_TROW(t) (lat ? ((t) < 32 ? b * SEQ + 64 * (t) : NLAT + b * CTXL + 64 * ((t) - 32)) : NLAT + b * CTXL + 64 * (t))
        bf16x8 Qf[2][3];
#pragma unroll
        for (int mb = 0; mb < 2; ++mb)
#pragma unroll
            for (int ks = 0; ks < 3; ++ks) Qf[mb][ks] = *(const GAS bf16x8*)(QKV + (size_t)(qrow0 + wave * 32 + mb * 16 + fr) * UPN + hd * 96 + 32 * ks + 8 * fq);
        f32x4 O[2][4], lsum[2]; float mrow[2];
#pragma unroll
        for (int mb = 0; mb < 2; ++mb) { mrow[mb] = -((const GAS float*)(wsb + WS_QM))[(size_t)(qrow0 + wave * 32 + mb * 16 + fr) * 8 + hd]; lsum[mb] = (f32x4){0.f, 0.f, 0.f, 0.f};
#pragma unroll
            for (int db = 0; db < 4; ++db) O[mb][db] = (f32x4){0.f, 0.f, 0.f, 0.f}; }
        const f32x4 Minit[2] = {(f32x4){mrow[0], mrow[0], mrow[0], mrow[0]}, (f32x4){mrow[1], mrow[1], mrow[1], mrow[1]}};
#define AT_DMA(gp, lp) asm volatile("s_mov_b32 m0, %1\n\ts_nop 0\n\tglobal_load_lds_dwordx4 %0, off" :: "v"(gp), "s"((unsigned)(__UINTPTR_TYPE__)(lp)) : "memory", "m0")
#define AT_LOADK(t, bufi) do { const int tr_ = AT_TROW(t); auto kb_ = KB + (bufi) * AT_KBUF + wave * 1024; \
            AT_DMA(KF + (size_t)(tr_ + krow_a) * 768 + hd * 96 + kc_a * 8, kb_); \
            if (wave < 4) AT_DMA(KF + (size_t)(tr_ + krow_b) * 768 + hd * 96 + kc_b * 8, kb_ + 8192); } while (0)
#define AT_LOADV(t, bufi) do { const int tr_ = AT_TROW(t); \
            AT_DMA(QKV + (size_t)(tr_ + vrow) * UPN + 768 + hd * 128 + 64 + vch * 8, VB + (bufi) * AT_VBUF + wave * 1024); } while (0)
#define AT_VTR(vbase, c, a, db) __builtin_amdgcn_ds_read_tr16_b64_v4i16((LAS s16x4_t*)((vbase) + (vtoff + 32 * ((db) ^ vsw)) + 4096 * (c) + 2048 * (a)))
#define AT_KFRAG(kbase, nb, ks) (*(const LAS bf16x8*)((kbase) + koff + (nb) * (16 * 192) + (ks) * 64))
#define AT_SINIT(Sx) do { _Pragma("unroll") for (int mb = 0; mb < 2; ++mb) _Pragma("unroll") for (int nb = 0; nb < 4; ++nb) Sx[mb][nb] = (f32x4){mrow[mb], mrow[mb], mrow[mb], mrow[mb]}; } while (0)
#define AT_CHUNK(Sx, i) do { f32x4 p_; _Pragma("unroll") for (int e_ = 0; e_ < 4; ++e_) p_[e_] = __builtin_amdgcn_exp2f(Sx[(i) >> 2][(i) & 3][e_]); Sx[(i) >> 2][(i) & 3] = p_; lsum[(i) >> 2] += p_; } while (0)
#define AT_MMA3(Sx, kf, ks, j0) do { _Pragma("unroll") for (int j_ = (j0); j_ < (j0) + 3 && j_ < 8; ++j_) Sx[j_ & 1][j_ >> 1] = __builtin_amdgcn_mfma_f32_16x16x32_bf16(kf[j_ >> 1], Qf[j_ & 1][ks], (ks) == 0 ? Minit[j_ & 1] : Sx[j_ & 1][j_ >> 1], 0, 0, 0); } while (0)
#define AT_SMAX(Sc, c) do { _Pragma("unroll") for (int mb = 0; mb < 2; ++mb) { AT_CHUNK(Sc, 4 * mb + 2 * (c)); AT_CHUNK(Sc, 4 * mb + 2 * (c) + 1); u32x4 w; \
                w.x = pg8::cvt_pk_bf16(Sc[mb][2 * (c)][0], Sc[mb][2 * (c)][1]); w.y = pg8::cvt_pk_bf16(Sc[mb][2 * (c)][2], Sc[mb][2 * (c)][3]); \
                w.z = pg8::cvt_pk_bf16(Sc[mb][2 * (c) + 1][0], Sc[mb][2 * (c) + 1][1]); w.w = pg8::cvt_pk_bf16(Sc[mb][2 * (c) + 1][2], Sc[mb][2 * (c) + 1][3]); Pf[mb][c] = __builtin_bit_cast(bf16x8, w); } } while (0)
#define AT_SMMA(Sc, nb0) do { _Pragma("unroll") for (int ks = 0; ks < 3; ++ks) _Pragma("unroll") for (int nb = (nb0); nb < (nb0) + 2; ++nb) _Pragma("unroll") for (int mb = 0; mb < 2; ++mb) \
                Sc[mb][nb] = __builtin_amdgcn_mfma_f32_16x16x32_bf16(kf[ks][nb], Qf[mb][ks], ks == 0 ? Minit[mb] : Sc[mb][nb], 0, 0, 0); } while (0)
#define AT_VFR(c) do { _Pragma("unroll") for (int db = 0; db < 4; ++db) { const s16x4_t lo_ = AT_VTR(vb2_, c, 0, db), hi_ = AT_VTR(vb2_, c, 1, db); vfr[c][db] = __builtin_shufflevector(lo_, hi_, 0, 1, 2, 3, 4, 5, 6, 7); } } while (0)
#define AT_PV(c) do { _Pragma("unroll") for (int db = 0; db < 4; ++db) _Pragma("unroll") for (int mb = 0; mb < 2; ++mb) O[mb][db] = __builtin_amdgcn_mfma_f32_16x16x32_bf16(vfr[c][db], Pf[mb][c], O[mb][db], 0, 0, 0); } while (0)
#define AT_TILE(Sc, t) do { \
            auto kc_ = KB + ((t) % 3) * AT_KBUF; auto vb2_ = VB + ((t) % 3) * AT_VBUF; \
            bf16x8 kf[3][4], vfr[2][4], Pf[2][2]; \
            _Pragma("unroll") for (int h = 0; h < 2; ++h) _Pragma("unroll") for (int ks = 0; ks < 3; ++ks) _Pragma("unroll") for (int nb = 2 * h; nb < 2 * h + 2; ++nb) kf[ks][nb] = AT_KFRAG(kc_, nb, ks); \
            if ((t) + 2 < nt) { AT_LOADK((t) + 2, ((t) + 2) % 3); AT_LOADV((t) + 2, ((t) + 2) % 3); }     \
            __builtin_amdgcn_sched_barrier(0); \
            AT_SMMA(Sc, 0); \
            __builtin_amdgcn_sched_barrier(0); \
            AT_VFR(0); AT_SMMA(Sc, 2); AT_SMAX(Sc, 0); \
            __builtin_amdgcn_sched_group_barrier(0x100, 8, 0); \
            _Pragma("unroll") for (int g_ = 0; g_ < 12; ++g_) { __builtin_amdgcn_sched_group_barrier(0x008, 1, 0); __builtin_amdgcn_sched_group_barrier(0x002, 4, 0); } \
            __builtin_amdgcn_sched_barrier(0); \
            AT_VFR(1); AT_PV(0); AT_SMAX(Sc, 1); \
            __builtin_amdgcn_sched_group_barrier(0x100, 8, 0); \
            _Pragma("unroll") for (int g_ = 0; g_ < 8; ++g_) { __builtin_amdgcn_sched_group_barrier(0x008, 1, 0); __builtin_amdgcn_sched_group_barrier(0x002, 6, 0); } \
            __builtin_amdgcn_sched_barrier(0); \
            AT_PV(1); \
            __builtin_amdgcn_sched_barrier(0); \
              \
            if ((t) + 2 < nt) { if (wave < 4) asm volatile("s_waitcnt vmcnt(3)" ::: "memory"); else asm volatile("s_waitcnt vmcnt(2)" ::: "memory"); } else asm volatile("s_waitcnt vmcnt(0)" ::: "memory"); \
            __syncthreads(); } while (0)
        __syncthreads();
        AT_LOADK(0, 0); AT_LOADV(0, 0); AT_LOADK(1, 1); AT_LOADV(1, 1);
        asm volatile("s_waitcnt vmcnt(0)" ::: "memory"); __syncthreads();
        f32x4 SA[2][4];
        for (int t = 0; t < nt; ++t) AT_TILE(SA, t);
#pragma unroll
        for (int mb = 0; mb < 2; ++mb) { float lt = (lsum[mb][0] + lsum[mb][1]) + (lsum[mb][2] + lsum[mb][3]); lt += __shfl_xor(lt, 16); lt += __shfl_xor(lt, 32); const float inv = 1.0f / lt;
            auto orow = MIX + (size_t)(qrow0 + wave * 32 + mb * 16 + fr) * D + 256 + hd * 64 + 4 * fq;
#pragma unroll
            for (int db = 0; db < 4; ++db) { const f32x4 o = O[mb][db] * inv; u32x2 w; w.x = pg8::cvt_pk_bf16(o[0], o[1]); w.y = pg8::cvt_pk_bf16(o[2], o[3]); *(GAS u32x2*)(orow + 16 * db) = w; } }
#undef AT_TROW
#undef AT_LOADK
#undef AT_DMA
#undef AT_LOADV
#undef AT_VTR
#undef AT_KFRAG
#undef AT_SINIT
#undef AT_CHUNK
#undef AT_MMA3
#undef AT_TILE
#undef AT_SMAX
#undef AT_SMMA
#undef AT_VFR
#undef AT_PV
    }
}

constexpr int ML_SLOT = 4224;
DI int ml_chunk_row0(int b, int c) { return c < 2 ? NLAT + b * CTXL + 128 * c : b * SEQ + 128 * (c - 2); }
DI void ml_gate_scan(const GAS bf16_t* Z, int row0, int hd, int dir, float bi, float bfg, int lane, LAS float* U, LAS float* BP, LAS float* CM, float& F, float& umax) {
    auto z0 = Z + (size_t)(row0 + lane) * ZW + ZGA; auto z1 = z0 + (size_t)64 * ZW;
    const float li0 = bf2f(z0[dir * 4 + hd]) + bi, li1 = bf2f(z1[dir * 4 + hd]) + bi;
    const float lf0 = log_sigmoid(bf2f(z0[8 + dir * 4 + hd]) + bfg), lf1 = log_sigmoid(bf2f(z1[8 + dir * 4 + hd]) + bfg);
    float s0 = lf0, s1 = lf1;
#pragma unroll
    for (int o = 1; o < 64; o <<= 1) { const float t0 = __shfl_up(s0, o), t1 = __shfl_up(s1, o); if (lane >= o) { s0 += t0; s1 += t1; } }
    const float tot0 = __shfl(s0, 63), tot1 = __shfl(s1, 63); F = tot0 + tot1; s1 += tot0;
    float b0, b1;
    if (dir == 0) { b0 = s0; b1 = s1; } else { b0 = F - s0 + lf0; b1 = F - s1 + lf1; }
    const float u0 = li0 - b0, u1 = li1 - b1;
    float c0 = u0, c1 = u1;
    if (dir == 0) {
#pragma unroll
        for (int o = 1; o < 64; o <<= 1) { const float t0 = __shfl_up(c0, o), t1 = __shfl_up(c1, o); if (lane >= o) { c0 = fmaxf(c0, t0); c1 = fmaxf(c1, t1); } }
        c1 = fmaxf(c1, __shfl(c0, 63)); umax = __shfl(c1, 63);
    } else {
#pragma unroll
        for (int o = 1; o < 64; o <<= 1) { const float t0 = __shfl_down(c0, o), t1 = __shfl_down(c1, o); if (lane + o < 64) { c0 = fmaxf(c0, t0); c1 = fmaxf(c1, t1); } }
        c0 = fmaxf(c0, __shfl(c1, 0)); umax = __shfl(c0, 0);
    }
    U[lane] = u0; U[lane + 64] = u1; BP[lane] = b0; BP[lane + 64] = b1; CM[lane] = c0; CM[lane + 64] = c1;
}
constexpr int ML_VST = 160;
#define ML_SWZ(row) (32 * (((row) >> 3) & 3))
DI void phase_ml1(const Params& P, GAS unsigned char* wsb, int l, LAS unsigned char* lds, const int tid) {
    const GAS bf16_t* Z = (const GAS bf16_t*)(wsb + WS_Z); GAS float* ST = (GAS float*)(wsb + WS_HD); GAS f32x4* GS = (GAS f32x4*)(wsb + WS_GS);
    const int lane = tid & 63, wave = __builtin_amdgcn_readfirstlane(tid >> 6), fr = lane & 15, fq = lane >> 4;
    LAS float* SCL = (LAS float*)lds; LAS float* GSL = (LAS float*)(lds + 66560);
    auto VT = lds + 4096; auto KT = lds + 4096 + 64 * ML_VST * 2;
    auto gb = P.in[opq_i(I_GATEB)] + l * 16;
    const int nunits = NB * 4 * 18, G = gridDim.x;
    for (int ub = blockIdx.x; ub < nunits; ub += 4 * G) {
        __syncthreads();
        { const int i = wave >> 1, dir = wave & 1, u = ub + i * G;
            if (u < nunits) { const int c = u % 18, bh = u / 18, hd = bh & 3, b = bh >> 2, row0 = ml_chunk_row0(b, c); float F, um;
                ml_gate_scan(Z, row0, hd, dir, gb[dir * 4 + hd], gb[8 + dir * 4 + hd], lane, GSL + i * 768 + dir * 128, GSL + i * 768 + 256 + dir * 128, GSL + i * 768 + 512 + dir * 128, F, um);
                if (lane == 0) { SCL[2 * i + dir] = um; auto s2 = ST + (size_t)(u * 2 + dir) * ML_SLOT; s2[4160] = F; s2[4161] = F + um; } } }
        __syncthreads();
        for (int idx = tid; idx < 4 * 192; idx += 512) { const int i = idx / 192, u = ub + i * G; if (u < nunits) GS[(size_t)u * 192 + (idx - i * 192)] = ((const LAS f32x4*)GSL)[idx]; }
        for (int i = 0; i < 4; ++i) {
            const int u = ub + i * G; if (u >= nunits) break;
            const int c = u % 18, bh = u / 18, hd = bh & 3, b = bh >> 2, row0 = ml_chunk_row0(b, c);
            auto sp = ST + (size_t)(u * 2) * ML_SLOT; const LAS float* U = GSL + i * 768; const LAS float* SC = SCL + 2 * i;
            __syncthreads();
            const int pp = tid >> 3, dc = tid & 7;
            auto zr = Z + (size_t)(row0 + 2 * pp) * ZW + hd * 64 + 8 * dc;
            const u32x4 k0 = *(const GAS u32x4*)(zr + ZKA), k1 = *(const GAS u32x4*)(zr + ZW + ZKA), v0 = *(const GAS u32x4*)(zr + ZVA), v1 = *(const GAS u32x4*)(zr + ZW + ZVA);
            {
                const float w00 = __expf(U[2 * pp] - SC[0]), w01 = __expf(U[2 * pp + 1] - SC[0]), w10 = __expf(U[128 + 2 * pp] - SC[1]), w11 = __expf(U[128 + 2 * pp + 1] - SC[1]);
                const unsigned ka[4] = {k0.x, k0.y, k0.z, k0.w}, kb[4] = {k1.x, k1.y, k1.z, k1.w}, va[4] = {v0.x, v0.y, v0.z, v0.w}, vb[4] = {v1.x, v1.y, v1.z, v1.w};
#pragma unroll
                for (int j = 0; j < 4; ++j) {
                    const int r0 = (8 * dc + 2 * j) * (ML_VST * 2) + ((pp * 4) ^ ML_SWZ(8 * dc)), r1 = r0 + ML_VST * 2;
                    *(LAS unsigned*)(VT + r0) = (va[j] & 0xffffu) | (vb[j] << 16);
                    *(LAS unsigned*)(VT + r1) = (va[j] >> 16) | (vb[j] & 0xffff0000u);
                    const float a0 = lo_f(ka[j]), a1 = hi_f(ka[j]), b0 = lo_f(kb[j]), b1 = hi_f(kb[j]);
                    *(LAS unsigned*)(KT + r0) = pk2(a0 * w00, b0 * w01); *(LAS unsigned*)(KT + r1) = pk2(a1 * w00, b1 * w01);
                    *(LAS unsigned*)(KT + 64 * ML_VST * 2 + r0) = pk2(a0 * w10, b0 * w11); *(LAS unsigned*)(KT + 64 * ML_VST * 2 + r1) = pk2(a1 * w10, b1 * w11);
                }
            }
            __syncthreads();
            {
                const int dir = wave >> 2, eb = wave & 3; auto kt = KT + dir * (64 * ML_VST * 2);
                f32x4 acc[4];
#pragma unroll
                for (int db = 0; db < 4; ++db) acc[db] = (f32x4){0.f, 0.f, 0.f, 0.f};
#pragma unroll
                for (int kp = 0; kp < 2; ++kp) {
                    bf16x8 af[2], bv[2][4];
#pragma unroll
                    for (int k2 = 0; k2 < 2; ++k2) { const int ks = 2 * kp + k2; af[k2] = *(const LAS bf16x8*)(VT + (16 * eb + fr) * (ML_VST * 2) + (((32 * ks + 8 * fq) * 2) ^ ML_SWZ(16 * eb + fr)));
#pragma unroll
                        for (int db = 0; db < 4; ++db) bv[k2][db] = *(const LAS bf16x8*)(kt + (16 * db + fr) * (ML_VST * 2) + (((32 * ks + 8 * fq) * 2) ^ ML_SWZ(16 * db + fr))); }
                    __builtin_amdgcn_sched_barrier(0);
#pragma unroll
                    for (int k2 = 0; k2 < 2; ++k2)
#pragma unroll
                        for (int db = 0; db < 4; ++db) acc[db] = __builtin_amdgcn_mfma_f32_16x16x32_bf16(bv[k2][db], af[k2], acc[db], 0, 0, 0);
                    __builtin_amdgcn_sched_barrier(0);
                }
                auto cp = sp + (size_t)dir * ML_SLOT + (16 * eb + fr) * 64 + 4 * fq;
#pragma unroll
                for (int db = 0; db < 4; ++db) *(GAS f32x4*)(cp + 16 * db) = acc[db];
                if (tid < 128) { const int d2 = tid >> 6, dd = tid & 63; auto kr = KT + d2 * (64 * ML_VST * 2) + dd * (ML_VST * 2); float sm = 0.f;
#pragma unroll
                    for (int i2 = 0; i2 < 16; ++i2) { const u32x4 t = *(const LAS u32x4*)(kr + 16 * i2); sm += (lo_f(t.x) + hi_f(t.x)) + (lo_f(t.y) + hi_f(t.y)) + (lo_f(t.z) + hi_f(t.z)) + (lo_f(t.w) + hi_f(t.w)); }
                    sp[(size_t)d2 * ML_SLOT + 4096 + dd] = sm; }
            }
        }
    }
}
DI void phase_ml2(GAS unsigned char* wsb, const int tid) {
    GAS float* ST = (GAS float*)(wsb + WS_HD);
    const int total = NB * 4 * 2 * 4160;
    for (int idx = blockIdx.x * 512 + tid; idx < total; idx += gridDim.x * 512) {
        const int chain = idx / 4160, el = idx - chain * 4160, dir = chain & 1, bh = chain >> 1;
        float cl[18], Fv[18], ml[18];
#pragma unroll
        for (int k = 0; k < 18; ++k) { const int c = dir == 0 ? k : (k < 2 ? 1 - k : 19 - k); auto sp = ST + (size_t)((bh * 18 + c) * 2 + dir) * ML_SLOT; cl[k] = sp[el]; Fv[k] = sp[4160]; ml[k] = sp[4161]; }
        float S = 0.f, m = 0.f;
#pragma unroll
        for (int k = 0; k < 18; ++k) { const int c = dir == 0 ? k : (k < 2 ? 1 - k : 19 - k); auto sp = ST + (size_t)((bh * 18 + c) * 2 + dir) * ML_SLOT;
            sp[el] = S; if (el == 0) sp[4162] = m;
            const float mn = fmaxf(Fv[k] + m, ml[k]); S = __expf(Fv[k] + m - mn) * S + __expf(ml[k] - mn) * cl[k]; m = mn; }
    }
}
constexpr int ML_KST = 80;
DI void phase_ml3(const Params& P, GAS unsigned char* wsb, int l, LAS unsigned char* lds0, const int tid0) {
    const GAS bf16_t* Z = (const GAS bf16_t*)(wsb + WS_Z); const GAS float* ST = (const GAS float*)(wsb + WS_HD); GAS bf16_t* MIX = (GAS bf16_t*)(wsb + WS_XN);
    auto mg = P.in[opq_i(I_MNG)] + l * 256;
    const int c_lo = l == 0 ? 0 : 2, ncs = 18 - c_lo, nunits = NB * 4 * ncs;
#define ML3_IDX(tt_) const int tid = (tt_), lane = tid & 63, wave = __builtin_amdgcn_readfirstlane(tid >> 6), fr = lane & 15, fq = lane >> 4, \
        pos = tid >> 2, q4 = tid & 3, pp = tid >> 3, dc = tid & 7, cdir = tid >> 8, ce = (tid & 255) >> 2, cd0 = (tid & 3) * 16, t = 16 * wave + fr
    u32x4 ka, kb, v0, v1; f32x4 c0, c1, c2, c3, gsv = {0.f, 0.f, 0.f, 0.f}; float nval = 0.f; bf16x8 Qn[2]; u32x2 own[4];
#define ML3_LOAD(u_) do { const int c_ = c_lo + (u_) % ncs, bh_ = (u_) / ncs, hd_ = bh_ & 3, row0_ = ml_chunk_row0(bh_ >> 2, c_); auto sp0_ = ST + (size_t)((bh_ * 18 + c_) * 2) * ML_SLOT; \
        auto zk_ = Z + (size_t)(row0_ + pos) * ZW + ZKA + hd_ * 64 + 16 * q4; ka = *(const GAS u32x4*)zk_; kb = *(const GAS u32x4*)(zk_ + 8); \
        auto zv_ = Z + (size_t)(row0_ + 2 * pp) * ZW + ZVA + hd_ * 64 + 8 * dc; v0 = *(const GAS u32x4*)zv_; v1 = *(const GAS u32x4*)(zv_ + ZW); \
        if (tid < 128) nval = sp0_[(size_t)(tid >> 6) * ML_SLOT + 4096 + (tid & 63)]; else if (tid < 130) nval = sp0_[(size_t)(tid - 128) * ML_SLOT + 4162]; \
        if (tid < 192) gsv = ((const GAS f32x4*)(wsb + WS_GS))[(size_t)(bh_ * 18 + c_) * 192 + tid]; } while (0)
#define ML3_STAGE(base_) do { auto KS_ = (base_) + 4096; auto VT_ = (base_) + 4096 + 128 * ML_KST * 2; \
        *(LAS u32x4*)(KS_ + pos * (ML_KST * 2) + 32 * q4) = ka; *(LAS u32x4*)(KS_ + pos * (ML_KST * 2) + 32 * q4 + 16) = kb; \
        { const unsigned va[4] = {v0.x, v0.y, v0.z, v0.w}, vb[4] = {v1.x, v1.y, v1.z, v1.w}; \
            _Pragma("unroll") for (int j = 0; j < 4; ++j) { const int r0 = (8 * dc + 2 * j) * (ML_VST * 2) + ((pp * 4) ^ ML_SWZ(8 * dc)); \
                *(LAS unsigned*)(VT_ + r0) = (va[j] & 0xffffu) | (vb[j] << 16); *(LAS unsigned*)(VT_ + r0 + ML_VST * 2) = (va[j] >> 16) | (vb[j] & 0xffff0000u); } } \
        } while (0)
#define ML3_STAGEC(base_) do { auto CT_ = (base_) + 45056; u32x4 w0, w1; w0.x = pg8::cvt_pk_bf16(c0[0], c0[1]); w0.y = pg8::cvt_pk_bf16(c0[2], c0[3]); w0.z = pg8::cvt_pk_bf16(c1[0], c1[1]); w0.w = pg8::cvt_pk_bf16(c1[2], c1[3]); \
            w1.x = pg8::cvt_pk_bf16(c2[0], c2[1]); w1.y = pg8::cvt_pk_bf16(c2[2], c2[3]); w1.z = pg8::cvt_pk_bf16(c3[0], c3[1]); w1.w = pg8::cvt_pk_bf16(c3[2], c3[3]); \
            auto cdst = CT_ + cdir * (64 * ML_KST * 2) + ce * (ML_KST * 2) + cd0 * 2; *(LAS u32x4*)cdst = w0; *(LAS u32x4*)(cdst + 16) = w1; } while (0)
#define ML3_LOADQ(u_) do { const int c_ = c_lo + (u_) % ncs, bh_ = (u_) / ncs, hd_ = bh_ & 3, row0_ = ml_chunk_row0(bh_ >> 2, c_); \
        _Pragma("unroll") for (int ks = 0; ks < 2; ++ks) Qn[ks] = *(const GAS bf16x8*)(Z + (size_t)(row0_ + t) * ZW + ZQA + hd_ * 64 + 32 * ks + 8 * fq); \
        _Pragma("unroll") for (int eb = 0; eb < 4; ++eb) own[eb] = *(const GAS u32x2*)(Z + (size_t)(row0_ + t) * ZW + ZOA + hd_ * 64 + 16 * eb + 4 * fq); \
        } while (0)
#define ML3_LOADC(u_) do { const int c_ = c_lo + (u_) % ncs, bh_ = (u_) / ncs, hd_ = bh_ & 3, row0_ = ml_chunk_row0(bh_ >> 2, c_); auto cp_ = ST + (size_t)((bh_ * 18 + c_) * 2 + cdir) * ML_SLOT + ce * 64 + cd0; \
        c0 = *(const GAS f32x4*)cp_; c1 = *(const GAS f32x4*)(cp_ + 4); c2 = *(const GAS f32x4*)(cp_ + 8); c3 = *(const GAS f32x4*)(cp_ + 12); } while (0)
    __syncthreads();
    if ((int)blockIdx.x < nunits) { ML3_IDX(tid0); ML3_LOAD((int)blockIdx.x); ML3_LOADC((int)blockIdx.x); ML3_LOADQ((int)blockIdx.x); ML3_STAGE(lds0); ML3_STAGEC(lds0); }
    int par = 0;
    for (int u = blockIdx.x; u < nunits; u += gridDim.x, par ^= 1) {
        int tl_ = tid0; asm volatile("" : "+v"(tl_)); ML3_IDX(tl_);
        auto lds = lds0 + par * 65536;
        LAS float* U = (LAS float*)lds; LAS float* BP = (LAS float*)(lds + 1024); LAS float* CM = (LAS float*)(lds + 2048);
        LAS float* MIN = (LAS float*)(lds + 3072); LAS float* NV = (LAS float*)(lds + 3200);
        auto KS = lds + 4096; auto VT = lds + 4096 + 128 * ML_KST * 2; auto CT = lds + 45056;
        const int c = c_lo + u % ncs, bh = u / ncs, hd = bh & 3, b = bh >> 2, row0 = ml_chunk_row0(b, c);
        const int trow = row0 + t;
        if (tid < 128) NV[tid] = nval; else if (tid < 130) MIN[tid - 128] = nval;
        if (tid < 192) ((LAS f32x4*)lds)[tid] = gsv;
        bf16x8 Qf[2]; u32x2 ow[4];
#pragma unroll
        for (int ks = 0; ks < 2; ++ks) Qf[ks] = Qn[ks];
#pragma unroll
        for (int eb = 0; eb < 4; ++eb) ow[eb] = own[eb];
        __syncthreads();
        const bool has_next = u + (int)gridDim.x < nunits;
        if (has_next) ML3_LOAD(u + (int)gridDim.x);
        f32x4 H[4];
#pragma unroll
        for (int eb = 0; eb < 4; ++eb) H[eb] = (f32x4){0.f, 0.f, 0.f, 0.f};
#pragma unroll
        for (int dir = 0; dir < 2; ++dir) {
            const float m_in = MIN[dir];
            const float Mt = fmaxf(m_in, CM[dir * 128 + t]);
            f32x4 S[8];
#pragma unroll
            for (int nb = 0; nb < 8; ++nb) S[nb] = (f32x4){0.f, 0.f, 0.f, 0.f};
#pragma unroll
            for (int h = 0; h < 2; ++h) {
                if (dir == 0 ? 4 * h <= wave : 4 * h + 3 >= wave) {
                    bf16x8 kf[4][2];
#pragma unroll
                    for (int n4 = 0; n4 < 4; ++n4)
#pragma unroll
                        for (int ks = 0; ks < 2; ++ks) kf[n4][ks] = *(const LAS bf16x8*)(KS + (16 * (4 * h + n4) + fr) * (ML_KST * 2) + (32 * ks + 8 * fq) * 2);
                    __builtin_amdgcn_sched_barrier(0);
#pragma unroll
                    for (int ks = 0; ks < 2; ++ks)
#pragma unroll
                        for (int n4 = 0; n4 < 4; ++n4) S[4 * h + n4] = __builtin_amdgcn_mfma_f32_16x16x32_bf16(kf[n4][ks], Qf[ks], S[4 * h + n4], 0, 0, 0);
                    __builtin_amdgcn_sched_barrier(0);
                } }
            float den = 0.f;
#pragma unroll
            for (int h = 0; h < 2; ++h) { f32x4 uu[4];
#pragma unroll
                for (int n4 = 0; n4 < 4; ++n4) uu[n4] = *(const LAS f32x4*)(U + dir * 128 + 16 * (4 * h + n4) + 4 * fq);
#pragma unroll
                for (int n4 = 0; n4 < 4; ++n4) { const int nb = 4 * h + n4;
#pragma unroll
                    for (int i = 0; i < 4; ++i) { const int sidx = 16 * nb + 4 * fq + i; const bool ok = dir == 0 ? sidx <= t : sidx >= t;
                        const float p = ok ? S[nb][i] * __expf(uu[n4][i] - Mt) : 0.f; S[nb][i] = p; den += p; } } }
            den += __shfl_xor(den, 16); den += __shfl_xor(den, 32);
            bf16x8 pf[4];
#pragma unroll
            for (int c4 = 0; c4 < 4; ++c4) { u32x4 w; w.x = pg8::cvt_pk_bf16(S[2 * c4][0], S[2 * c4][1]); w.y = pg8::cvt_pk_bf16(S[2 * c4][2], S[2 * c4][3]);
                w.z = pg8::cvt_pk_bf16(S[2 * c4 + 1][0], S[2 * c4 + 1][1]); w.w = pg8::cvt_pk_bf16(S[2 * c4 + 1][2], S[2 * c4 + 1][3]); pf[c4] = __builtin_bit_cast(bf16x8, w); }
            f32x4 N[4];
#pragma unroll
            for (int eb = 0; eb < 4; ++eb) N[eb] = (f32x4){0.f, 0.f, 0.f, 0.f};
#pragma unroll
            for (int c4 = 0; c4 < 4; ++c4) {
                if (dir == 0 ? 2 * c4 <= wave : 2 * c4 + 1 >= wave) {
                    u32x2 vx[4][2];
#pragma unroll
                    for (int eb = 0; eb < 4; ++eb) { auto vp = VT + (16 * eb + fr) * (ML_VST * 2); const int vo = (32 * c4 + 4 * fq) * 2, vs = ML_SWZ(16 * eb + fr);
                        vx[eb][0] = *(const LAS u32x2*)(vp + (vo ^ vs)); vx[eb][1] = *(const LAS u32x2*)(vp + ((vo + 32) ^ vs)); }
#pragma unroll
                    for (int eb = 0; eb < 4; ++eb) { u32x4 vw; vw.x = vx[eb][0].x; vw.y = vx[eb][0].y; vw.z = vx[eb][1].x; vw.w = vx[eb][1].y;
                        N[eb] = __builtin_amdgcn_mfma_f32_16x16x32_bf16(__builtin_bit_cast(bf16x8, vw), pf[c4], N[eb], 0, 0, 0); }
                } }
            bf16x8 cf[4][2]; f32x4 nv[2][2];
#pragma unroll
            for (int eb = 0; eb < 4; ++eb)
#pragma unroll
                for (int ks = 0; ks < 2; ++ks) cf[eb][ks] = *(const LAS bf16x8*)(CT + dir * (64 * ML_KST * 2) + (16 * eb + fr) * (ML_KST * 2) + (32 * ks + 8 * fq) * 2);
#pragma unroll
            for (int ks = 0; ks < 2; ++ks) { auto np = NV + dir * 64 + 32 * ks + 8 * fq; nv[ks][0] = *(const LAS f32x4*)np; nv[ks][1] = *(const LAS f32x4*)(np + 4); }
            __builtin_amdgcn_sched_barrier(0);
            f32x4 QC[4];
#pragma unroll
            for (int eb = 0; eb < 4; ++eb) { QC[eb] = (f32x4){0.f, 0.f, 0.f, 0.f};
#pragma unroll
                for (int ks = 0; ks < 2; ++ks) QC[eb] = __builtin_amdgcn_mfma_f32_16x16x32_bf16(cf[eb][ks], Qf[ks], QC[eb], 0, 0, 0); }
            float qn = 0.f;
#pragma unroll
            for (int ks = 0; ks < 2; ++ks) { const f32x4 n0 = nv[ks][0], n1 = nv[ks][1]; const u32x4 qw = __builtin_bit_cast(u32x4, Qf[ks]);
                qn += lo_f(qw.x) * n0[0] + hi_f(qw.x) * n0[1] + lo_f(qw.y) * n0[2] + hi_f(qw.y) * n0[3] + lo_f(qw.z) * n1[0] + hi_f(qw.z) * n1[1] + lo_f(qw.w) * n1[2] + hi_f(qw.w) * n1[3]; }
            qn += __shfl_xor(qn, 16); qn += __shfl_xor(qn, 32);
            const float a = __expf(m_in - Mt), dent = den + a * qn;
            const float rden = 1.0f / fmaxf(fabsf(dent), __expf(-(BP[dir * 128 + t] + Mt)));
#pragma unroll
            for (int eb = 0; eb < 4; ++eb) H[eb] = H[eb] + (N[eb] + QC[eb] * a) * rden;
            if (has_next) { if (dir == 0) { ML3_STAGE(lds0 + (par ^ 1) * 65536); ML3_LOADC(u + (int)gridDim.x); } else { ML3_STAGEC(lds0 + (par ^ 1) * 65536); ML3_LOADQ(u + (int)gridDim.x); } }
        }
        float ssq = 0.f;
#pragma unroll
        for (int eb = 0; eb < 4; ++eb) ssq += (H[eb][0] * H[eb][0] + H[eb][1] * H[eb][1]) + (H[eb][2] * H[eb][2] + H[eb][3] * H[eb][3]);
        ssq += __shfl_xor(ssq, 16); ssq += __shfl_xor(ssq, 32);
        const float r = 1.0f / sqrtf(ssq * (1.0f / 64.0f) + EPS);
#pragma unroll
        for (int eb = 0; eb < 4; ++eb) { const int e0 = hd * 64 + 16 * eb + 4 * fq; const f32x4 g4 = *(const GAS f32x4*)(mg + e0);
            u32x2 w; w.x = pg8::cvt_pk_bf16(sigmoidf_(lo_f(ow[eb].x)) * (H[eb][0] * r * g4[0]), sigmoidf_(hi_f(ow[eb].x)) * (H[eb][1] * r * g4[1]));
            w.y = pg8::cvt_pk_bf16(sigmoidf_(lo_f(ow[eb].y)) * (H[eb][2] * r * g4[2]), sigmoidf_(hi_f(ow[eb].y)) * (H[eb][3] * r * g4[3]));
            *(GAS u32x2*)(MIX + (size_t)trow * D + e0) = w; }
    }
}

#undef ML3_LOAD
#undef ML3_STAGE
#undef ML3_IDX
#undef ML3_LOADC
#undef ML3_LOADQ
#undef ML3_STAGEC
DI void phase_gmlp(const Params& P, GAS unsigned char* wsb, int l, LAS unsigned char* lds, const int tid) {
    const GAS bf16_t* Z = (const GAS bf16_t*)(wsb + WS_Z); const GAS bf16_t* VLN = (const GAS bf16_t*)(wsb + WS_VLN); GAS bf16_t* MIX = (GAS bf16_t*)(wsb + WS_XN);
    const GAS bf16_t* WSB = (const GAS bf16_t*)(wsb + WS_WS) + (size_t)l * 4 * 128 * 128; auto bsp = P.in[opq_i(I_BS)] + l * 4 * 128;
    const int lane = tid & 63, wave = __builtin_amdgcn_readfirstlane(tid >> 6), fr = lane & 15, fq = lane >> 4;
    auto VT = lds;
    const int nunits = l == 0 ? 288 : 256;
    for (int u = blockIdx.x; u < nunits; u += gridDim.x) {
        const int row0 = u < 256 ? u * 128 : NLAT + (u - 256) * 128;
        const int p = 16 * wave + fr, row = row0 + p;
        __syncthreads();
        u32x4 sv0[4], sv1[4];
#pragma unroll
        for (int i = 0; i < 4; ++i) { const int task = tid + 512 * i, pp = ((task >> 2) & 7) | ((task >> 8) << 3), fc = (task & 3) | (((task >> 5) & 7) << 2);
            auto vr = VLN + (size_t)(row0 + 2 * pp) * 256 + 8 * fc; sv0[i] = *(const GAS u32x4*)vr; sv1[i] = *(const GAS u32x4*)(vr + 256); }
        bf16x8 af[4][4];
#pragma unroll
        for (int ks = 0; ks < 4; ++ks)
#pragma unroll
            for (int g = 0; g < 4; ++g) af[ks][g] = *(const GAS bf16x8*)(WSB + ((size_t)g * 128 + p) * 128 + 32 * ks + 8 * fq);
        u32x2 uwv[4][4]; float bsv[4];
#pragma unroll
        for (int g = 0; g < 4; ++g) { bsv[g] = bsp[g * 128 + p];
#pragma unroll
            for (int nb = 0; nb < 4; ++nb) uwv[g][nb] = *(const GAS u32x2*)(Z + (size_t)row * ZW + ZGU + g * 64 + 16 * nb + 4 * fq); }
#pragma unroll
        for (int i = 0; i < 4; ++i) { const int task = tid + 512 * i, pp = ((task >> 2) & 7) | ((task >> 8) << 3), fc = (task & 3) | (((task >> 5) & 7) << 2);
            const unsigned va[4] = {sv0[i].x, sv0[i].y, sv0[i].z, sv0[i].w}, vb[4] = {sv1[i].x, sv1[i].y, sv1[i].z, sv1[i].w};
#pragma unroll
            for (int j = 0; j < 4; ++j) { const int r0 = (8 * fc + 2 * j) * (ML_VST * 2) + ((pp * 4) ^ ML_SWZ(8 * fc));
                *(LAS unsigned*)(VT + r0) = (va[j] & 0xffffu) | (vb[j] << 16); *(LAS unsigned*)(VT + r0 + ML_VST * 2) = (va[j] >> 16) | (vb[j] & 0xffff0000u); } }
        __syncthreads();
        f32x4 acc[4][4];
#pragma unroll
        for (int g = 0; g < 4; ++g)
#pragma unroll
            for (int nb = 0; nb < 4; ++nb) acc[g][nb] = (f32x4){0.f, 0.f, 0.f, 0.f};
#pragma unroll
        for (int ks = 0; ks < 4; ++ks)
#pragma unroll
            for (int g2 = 0; g2 < 2; ++g2) {
                bf16x8 bv[2][4];
#pragma unroll
                for (int gg = 0; gg < 2; ++gg)
#pragma unroll
                    for (int nb = 0; nb < 4; ++nb) bv[gg][nb] = *(const LAS bf16x8*)(VT + ((2 * g2 + gg) * 64 + 16 * nb + fr) * (ML_VST * 2) + (((32 * ks + 8 * fq) * 2) ^ ML_SWZ(16 * nb + fr)));
                __builtin_amdgcn_sched_barrier(0);
#pragma unroll
                for (int gg = 0; gg < 2; ++gg)
#pragma unroll
                    for (int nb = 0; nb < 4; ++nb) acc[2 * g2 + gg][nb] = __builtin_amdgcn_mfma_f32_16x16x32_bf16(bv[gg][nb], af[ks][2 * g2 + gg], acc[2 * g2 + gg][nb], 0, 0, 0);
                __builtin_amdgcn_sched_barrier(0);
            }
#pragma unroll
        for (int g = 0; g < 4; ++g) { const float bs = bsv[g];
#pragma unroll
            for (int nb = 0; nb < 4; ++nb) { const int col = g * 64 + 16 * nb + 4 * fq; const u32x2 uw = uwv[g][nb];
                u32x2 w; w.x = pg8::cvt_pk_bf16(gelu_tanh(lo_f(uw.x)) * (acc[g][nb][0] + bs), gelu_tanh(hi_f(uw.x)) * (acc[g][nb][1] + bs));
                w.y = pg8::cvt_pk_bf16(gelu_tanh(lo_f(uw.y)) * (acc[g][nb][2] + bs), gelu_tanh(hi_f(uw.y)) * (acc[g][nb][3] + bs));
                *(GAS u32x2*)(MIX + (size_t)row * D + 768 + col) = w; } }
    }
}

DI void phase_route(const Params& P, GAS unsigned char* wsb, LAS unsigned char* lds, const int tid) {
    LAS int* tot = (LAS int*)lds; auto pre = tot + 8; auto base = tot + 16; auto ae = tot + 32;
    const GAS unsigned* bc = (const GAS unsigned*)wsb + CW_BCNT; const GAS int* ti = (const GAS int*)(wsb + WS_TOPI);
    GAS int* tokslot = (GAS int*)(wsb + WS_TOKSLOT); GAS int* slottok = (GAS int*)(wsb + WS_SLOTTOK);
    const int blk = blockIdx.x;
    {
        const int e = tid >> 6, ln = tid & 63; int t = 0, p = 0;
#pragma unroll
        for (int i = 0; i < 4; ++i) { const int c = ln + 64 * i; const int v = (int)bc[c * 8 + e]; t += v; p += c < blk ? v : 0; }
        t = wave_sum_i(t); p = wave_sum_i(p);
        if (ln == 0) { tot[e] = t; pre[e] = p; } }
    if (tid < 256) ae[tid] = ti[(blk * 128) * 2 + tid];
    __syncthreads();
    if (tid == 0) { int s = 0; for (int e = 0; e < 8; ++e) { base[e] = s; s += (tot[e] + 255) & ~255; } base[8] = s; }
    __syncthreads();
    if (tid < 256) { const int e = ae[tid]; int rank = 0; for (int a = 0; a < tid; ++a) rank += (ae[a] == e) ? 1 : 0;
        const int slot = base[e] + pre[e] + rank; const int token = blk * 128 + (tid >> 1);
        slottok[slot] = token; tokslot[token * 2 + (tid & 1)] = slot; }
    if (blk < 8) { const int e = blk; for (int s = base[e] + tot[e] + tid; s < base[e + 1]; s += 512) slottok[s] = 0; }
    if (blk == 0) { GAS unsigned* cw = (GAS unsigned*)wsb;
        if (tid == 0) cw[CW_NT] = (unsigned)(base[8] >> 8);
        if (tid < 7) cw[CW_TEXP + tid] = (unsigned)(base[tid + 1] >> 8);
 }
}

DI void phase_combine(const Params& P, GAS unsigned char* wsb, int gw, int NGW, int lane) {
    const GAS float* modl = (const GAS float*)(wsb + WS_MOD) + (size_t)1 * 17 * 6144;
    const GAS int* tokslot = (const GAS int*)(wsb + WS_TOKSLOT); const GAS float* tg = (const GAS float*)(wsb + WS_TOPG); const GAS bf16_t* Y = (const GAS bf16_t*)(wsb + WS_Y);
    u32x2 y0c[4], y1c[4], xc[4]; float w0c = 0.f, w1c = 0.f; int s0n = 0, s1n = 0; float w0n = 0.f, w1n = 0.f;
#define CB_IDX(row_) do { s0n = tokslot[2 * (row_)]; s1n = tokslot[2 * (row_) + 1]; w0n = tg[2 * (row_)]; w1n = tg[2 * (row_) + 1]; } while (0)
#define CB_ROWS(row_, ya, yb, xx) do { const GAS u32x2* x3_ = (const GAS u32x2*)((const GAS bf16_t*)(wsb + WS_X3) + (size_t)(row_) * D); \
        _Pragma("unroll") for (int j = 0; j < 4; ++j) { const int c4 = 64 * j + lane; ya[j] = *(const GAS u32x2*)(Y + (size_t)s0n * D + 4 * c4); yb[j] = *(const GAS u32x2*)(Y + (size_t)s1n * D + 4 * c4); xx[j] = x3_[c4]; } } while (0)
    if (gw < NLAT) { CB_IDX(gw); CB_ROWS(gw, y0c, y1c, xc); w0c = w0n; w1c = w1n; if (gw + NGW < NLAT) CB_IDX(gw + NGW); }
    for (int row = gw; row < NLAT; row += NGW) {
        auto g2 = modl + (size_t)(row >> 11) * 6144 + 5 * D;
        u32x2 y0n[4], y1n[4], xn[4]; const float w0x = w0n, w1x = w1n;
#pragma unroll
        for (int j = 0; j < 4; ++j) { y0n[j] = y0c[j]; y1n[j] = y1c[j]; xn[j] = xc[j]; }
        if (row + NGW < NLAT) { CB_ROWS(row + NGW, y0n, y1n, xn); if (row + 2 * NGW < NLAT) CB_IDX(row + 2 * NGW); }
        GAS f32x4* xr = (GAS f32x4*)(P.out + (size_t)row * D);
#pragma unroll
        for (int j = 0; j < 4; ++j) { const int c4 = 64 * j + lane;
            const u32x2 y0 = y0c[j], y1 = y1c[j];
            const f32x4 gv = ((const GAS f32x4*)g2)[c4]; const u32x2 xw = xc[j]; f32x4 x = (f32x4){lo_f(xw.x), hi_f(xw.x), lo_f(xw.y), hi_f(xw.y)};
            x.x += gv.x * (w0c * lo_f(y0.x) + w1c * lo_f(y1.x)); x.y += gv.y * (w0c * hi_f(y0.x) + w1c * hi_f(y1.x));
            x.z += gv.z * (w0c * lo_f(y0.y) + w1c * lo_f(y1.y)); x.w += gv.w * (w0c * hi_f(y0.y) + w1c * hi_f(y1.y));
            xr[c4] = x; }
#pragma unroll
        for (int j = 0; j < 4; ++j) { y0c[j] = y0n[j]; y1c[j] = y1n[j]; xc[j] = xn[j]; }
        w0c = w0x; w1c = w1x;
    }
#undef CB_IDX
#undef CB_ROWS
}

constexpr int NPHASE = 17 + 9 + 2 * NBATCH + 1;
constexpr int MF0 = 0, MF1 = 6656, MF2 = 14336, MF3 = 22656, MF4 = 40704, MF_END = 43008;
#define MOE_FILL(first_short, lo_, hi_) do { if (bid >= (first_short)) { __syncthreads(); run_jobs(P, NJOBS_PRO, NJOBS, (lo_), (hi_) < P.n_items_moe ? (hi_) : P.n_items_moe, lds, (bid - (first_short)) * 8 + wave, (G - (first_short)) * 8, wave, lane); } } while (0)
#define PH_VARS const int wave = opq_i(wave0); const int lane = opq_lane(); const int t_ = wave * 64 + lane; const int gw = blockIdx.x * 8 + wave; \
    auto ws = opq_p(P.ws); const int bid = opq_i((int)blockIdx.x); (void)lane; (void)wave; (void)gw; (void)ws; (void)bid;
__global__ void __launch_bounds__(512, 2) fwd_kernel(Params P) {
    extern __shared__ __attribute__((aligned(16))) unsigned char lds_raw[];
    LAS unsigned char* lds = (LAS unsigned char*)lds_raw;
    const int G = gridDim.x, NGW = G * 8;
    const int wave0 = __builtin_amdgcn_readfirstlane((int)threadIdx.x >> 6);
    volatile LAS unsigned* MISC = (volatile LAS unsigned*)(lds + LDSCTL_OFF);
    if (threadIdx.x < 64) MISC[threadIdx.x] = 0u;
    __syncthreads();
    unsigned* ctl = (unsigned*)P.ws;
    XcdBarrier bar; bar.bar = ctl + CW_BAR; bar.x = 0; bar.st = MISC + 8;
    const bool multi = (P.ph_hi - P.ph_lo) > 1;
    if (multi) bar = xcd_barrier_post(ctl + CW_BAR, MISC + 8);
    const int lo = P.ph_lo, hi = P.ph_hi;
#define IN(k) (lo <= (k) && (k) < hi)
#define SEAM(k) do { if (IN(k) && IN((k) + 1)) { XcdBarrier b2_ = bar; b2_.bar = (unsigned*)opq_p((unsigned char*)bar.bar); xcd_barrier(b2_); } } while (0)

    if (IN(0)) {
        PH_VARS
        const int tid = t_;
        if (blockIdx.x < 192) {
            LAS float* sc = (LAS float*)lds; LAS float* red = (LAS float*)(lds + 69632);
            auto c = P.in[opq_i(I_C)]; auto cc = P.in[opq_i(I_CCTX)];
            for (int i = tid; i < 17 * 1024; i += 512) { const int r = i >> 10, k = i & 1023; const float cv = r < 16 ? c[r * 1024 + k] : cc[k]; sc[i] = cv / (1.0f + __expf(-cv)); }
            __syncthreads();
            const int l = blockIdx.x / 96, j0 = (blockIdx.x % 96) * 64, cg = tid & 15, kgp = tid >> 4, kg = tid >> 6;
            f32x4 acc[17];
#pragma unroll
            for (int r = 0; r < 17; ++r) acc[r] = (f32x4){0.f, 0.f, 0.f, 0.f};
            auto w = P.in[opq_i(I_ADAW)] + (size_t)l * 1024 * 6144 + j0 + 4 * cg;
#pragma unroll 1
            for (int kb = 0; kb < 32; kb += 16) { f32x4 wv[16];
#pragma unroll
                for (int i = 0; i < 16; ++i) wv[i] = *(const GAS f32x4*)(w + (size_t)(kgp * 32 + kb + i) * 6144);
#pragma unroll
                for (int i = 0; i < 16; ++i) { const int k = kgp * 32 + kb + i;
#pragma unroll
                    for (int r = 0; r < 17; ++r) acc[r] += wv[i] * sc[r * 1024 + k]; } }
#pragma unroll
            for (int r = 0; r < 17; ++r) {
#pragma unroll
                for (int e = 0; e < 4; ++e) { float t = acc[r][e]; t += __shfl_xor(t, 16); t += __shfl_xor(t, 32); acc[r][e] = t; }
                if ((tid & 63) < 16) *(LAS f32x4*)(red + (kg * 17 + r) * 64 + 4 * cg) = acc[r]; }
            __syncthreads();
            GAS float* mod = (GAS float*)(ws + WS_MOD);
            for (int o = tid; o < 17 * 64; o += 512) { const int r = o >> 6, c2 = o & 63; float sm = 0.f;
#pragma unroll
                for (int g8 = 0; g8 < 8; ++g8) sm += red[(g8 * 17 + r) * 64 + c2];
                mod[((size_t)l * 17 + r) * 6144 + j0 + c2] = sm + P.in[opq_i(I_ADAB)][l * 6144 + j0 + c2]; }
        }
        __syncthreads();
        run_jobs(P, 0, NJOBS_PRO, 0, P.n_items_pro, lds, gw, NGW, wave, lane);
        { auto wsf = P.in[opq_i(I_WS)]; GAS bf16_t* wsb16 = (GAS bf16_t*)(ws + WS_WS); for (int i = blockIdx.x * 512 + tid; i < 2 * 4 * 128 * 128 / 2; i += G * 512) ((GAS unsigned*)wsb16)[i] = pk2(wsf[2 * i], wsf[2 * i + 1]); }
        for (int l = 0; l < 2; ++l) {
            GAS u32x4* wp = (GAS u32x4*)((GAS bf16_t*)(ws + WS_WIN) + (size_t)l * ZW * D + (size_t)1456 * D);
            for (int i = blockIdx.x * 512 + tid; i < 80 * D / 8; i += G * 512) wp[i] = (u32x4){0u, 0u, 0u, 0u};
        }
    }
    SEAM(0);

    for (int l = 0; l < 2; ++l) {
        const int pb = 1 + 16 * l;
        if (IN(pb + 0)) { PH_VARS
            if (l == 0) phase_norm<false, false, false>(P, ws, 0, 0, NTOK, (const GAS void*)P.in[opq_i(I_X)], (const GAS void*)P.in[opq_i(I_CTX)], (GAS bf16_t*)(ws + WS_XN), lds, t_, wave, lane);
            else phase_norm<false, false, true>(P, ws, 1, 0, NTOK, (const GAS void*)P.out, (const GAS void*)(ws + WS_XC), (GAS bf16_t*)(ws + WS_XN), lds, t_, wave, lane); }
        SEAM(pb + 0);
        if (IN(pb + 1)) { PH_VARS
            pg8::Gemm g{(const GAS bf16_t*)(ws + WS_XN), (const GAS bf16_t*)(ws + WS_WIN) + (size_t)l * ZW * D, D, D, nullptr}; pg8::StaticOrder S; S.init(NTOK, ZW, G, bid);
            pg8::EpiBf16 E{(GAS bf16_t*)(ws + WS_Z), ZW, 1.0f};
            pg8::gemm_phase<pg8::EpiBf16, pg8::StaticOrder, false>(lds, g, S, E, t_);
            if (l == 0) MOE_FILL(128, MF0, MF1); else MOE_FILL(128, MF4, MF_END);
        }
        SEAM(pb + 1);
        if (IN(pb + 2)) { PH_VARS
            phase_ml1(P, ws, l, lds, t_); phase_prep(P, ws, l, gw, NGW, lane);
            __syncthreads();
            pg8::Gemm g{(const GAS bf16_t*)(ws + WS_Z) + ZCQ, (const GAS bf16_t*)(ws + WS_BUP) + (size_t)l * UPN * UPK, UPK, ZW, nullptr}; pg8::UpOrder S{G, bid};
            pg8::EpiBf16 E{(GAS bf16_t*)(ws + WS_QKV), UPN, 1.0f};
            pg8::gemm_phase<pg8::EpiBf16, pg8::UpOrder, false>(lds, g, S, E, t_);
        }
        SEAM(pb + 2);
        if (IN(pb + 4)) { PH_VARS
            phase_ml2(ws, t_); phase_qk(P, ws, l, gw, NGW, lane); phase_gmlp(P, ws, l, lds, t_); }
        SEAM(pb + 4);
        if (IN(pb + 5)) { PH_VARS
            phase_attn(P, ws, l, lds, t_); phase_ml3(P, ws, l, lds, t_); }
        SEAM(pb + 5);
        if (IN(pb + 6)) { PH_VARS
            pg8::Gemm g{(const GAS bf16_t*)(ws + WS_XN), (const GAS bf16_t*)(ws + WS_WOUT) + (size_t)l * D * D, D, D, nullptr}; pg8::StaticOrder S; S.init(l == 0 ? NTOK : NLAT, D, G, bid);
            if (l == 0) { pg8::EpiResidT<true> E{(const GAS void*)P.in[opq_i(I_X)], (const GAS void*)P.in[opq_i(I_CTX)], (GAS bf16_t*)P.out, (GAS bf16_t*)(ws + WS_XC), (const GAS float*)(ws + WS_MOD), 2 * D};
                pg8::gemm_phase<pg8::EpiResidT<true>, pg8::StaticOrder, false>(lds, g, S, E, t_); MOE_FILL(64, MF1, MF2); }
            else { pg8::EpiResidT<false> E{(const GAS void*)P.out, (const GAS void*)(ws + WS_XC), (GAS bf16_t*)(ws + WS_X3), (GAS bf16_t*)(ws + WS_XC), (const GAS float*)(ws + WS_MOD) + (size_t)17 * 6144, 2 * D};
                pg8::gemm_phase<pg8::EpiResidT<false>, pg8::StaticOrder, false>(lds, g, S, E, t_); }
            if (l == 1) { __syncthreads(); run_jobs(P, NJOBS_PRO, NJOBS, MF_END, P.n_items_moe, lds, gw, NGW, wave, lane); }
        }
        SEAM(pb + 6);
        if (IN(pb + 7)) { PH_VARS
            if (l == 0) phase_norm<false, false, true>(P, ws, 0, 1, NTOK, (const GAS void*)P.out, (const GAS void*)(ws + WS_XC), (GAS bf16_t*)(ws + WS_XN), lds, t_, wave, lane);
            else phase_norm<true, true, true>(P, ws, 1, 1, NLAT, (const GAS void*)(ws + WS_X3), (const GAS void*)(ws + WS_XC), (GAS bf16_t*)(ws + WS_XN), lds, t_, wave, lane); }
        SEAM(pb + 7);
        if (l == 0) {
            if (IN(pb + 8)) { PH_VARS
                pg8::Gemm g{(const GAS bf16_t*)(ws + WS_XN), (const GAS bf16_t*)(ws + WS_W13D), D, D, nullptr}; pg8::StaticOrder S; S.init(NTOK, 2 * DFF, G, bid);
                pg8::EpiSwiglu E{(GAS bf16_t*)(ws + WS_G0), DFF, 0, 1.0f};
                pg8::gemm_phase<pg8::EpiSwiglu, pg8::StaticOrder, false, false>(lds, g, S, E, t_);
                MOE_FILL(96, MF2, MF3);
            }
            SEAM(pb + 8);
            if (IN(pb + 9)) { PH_VARS
                pg8::Gemm g{(const GAS bf16_t*)(ws + WS_G0), (const GAS bf16_t*)(ws + WS_W2D), DFF, DFF, nullptr}; pg8::StaticOrder S; S.init(NTOK, D, G, bid);
                pg8::EpiResidT<false> E{(const GAS void*)P.out, (const GAS void*)(ws + WS_XC), (GAS bf16_t*)P.out, (GAS bf16_t*)(ws + WS_XC), (const GAS float*)(ws + WS_MOD), 5 * D};
                pg8::gemm_phase<pg8::EpiResidT<false>, pg8::StaticOrder, false>(lds, g, S, E, t_);
                MOE_FILL(64, MF3, MF4);
            }
            SEAM(pb + 9);
        } else {
            if (IN(pb + 8)) { PH_VARS
                phase_route(P, ws, lds, t_); }
            SEAM(pb + 8);
            for (int bt = 0; bt < NBATCH; ++bt) {
                if (IN(pb + 9 + 2 * bt)) { PH_VARS
                    const GAS unsigned* cw = (const GAS unsigned*)ws;
                    const int nT = (int)cw[CW_NT]; const int t0 = bt * TB; int n = nT - t0; n = n < 0 ? 0 : (n > TB ? TB : n);
                    pg8::Gemm g{(const GAS bf16_t*)(ws + WS_XN), (const GAS bf16_t*)(ws + WS_W13M), D, D, (const GAS int*)(ws + WS_SLOTTOK)}; pg8::MoeOrder S{t0, n, 2 * DFFE / 256, G, bid, {(int)cw[CW_TEXP], (int)cw[CW_TEXP + 1], (int)cw[CW_TEXP + 2], (int)cw[CW_TEXP + 3], (int)cw[CW_TEXP + 4], (int)cw[CW_TEXP + 5], (int)cw[CW_TEXP + 6]}};
                    pg8::EpiSwiglu8 E{(GAS bf16_t*)(ws + WS_GM), DFFE, t0, 1.0f / (H8_SCALE * W8_SCALE)};
                    pg8::gemm_phase<pg8::EpiSwiglu8, pg8::MoeOrder, true, true>(lds, g, S, E, t_);
                }
                SEAM(pb + 9 + 2 * bt);
                if (IN(pb + 10 + 2 * bt)) { PH_VARS
                    const GAS unsigned* cw = (const GAS unsigned*)ws;
                    const int nT = (int)cw[CW_NT]; const int t0 = bt * TB; int n = nT - t0; n = n < 0 ? 0 : (n > TB ? TB : n);
                    pg8::Gemm g{(const GAS bf16_t*)(ws + WS_GM - (size_t)t0 * 256 * DFFE), (const GAS bf16_t*)(ws + WS_W2M), DFFE, DFFE, nullptr}; pg8::MoeOrder S{t0, n, D / 256, G, bid, {(int)cw[CW_TEXP], (int)cw[CW_TEXP + 1], (int)cw[CW_TEXP + 2], (int)cw[CW_TEXP + 3], (int)cw[CW_TEXP + 4], (int)cw[CW_TEXP + 5], (int)cw[CW_TEXP + 6]}};
                    pg8::EpiBf16 E{(GAS bf16_t*)(ws + WS_Y), D, 1.0f / (G8_SCALE * W28_SCALE)};
                    pg8::gemm_phase<pg8::EpiBf16, pg8::MoeOrder, false, true>(lds, g, S, E, t_);
                }
                SEAM(pb + 10 + 2 * bt);
            }
            if (IN(pb + 9 + 2 * NBATCH)) { PH_VARS
                phase_combine(P, ws, gw, NGW, lane); }
        }
    }
#undef IN
#undef SEAM
}

static void add_job(Params& p, int& nj, int& items, const float* src, const float* kgain, bf16_t* dst, int K, int N, int src_col0, int ncols, int dst_row0, int dst_k0, int dst_ld,
                    int grp, int grp_stride, int nbatch, int src_bstride, int dst_bstride, float scale, int fp8 = 0) {
    TJob& j = p.jobs[nj++];
    j.src = src; j.kgain = kgain; j.dst = dst; j.K = K; j.N = N; j.src_col0 = src_col0; j.ncols = ncols; j.dst_row0 = dst_row0; j.dst_k0 = dst_k0; j.dst_ld = dst_ld;
    j.grp = grp; j.grp_stride = grp_stride; j.nbatch = nbatch; j.src_bstride = src_bstride; j.dst_bstride = dst_bstride; j.scale = scale; j.item0 = items; j.fp8 = fp8;
    items += nbatch * (K / 64) * ((ncols + 31) / 32);
}

extern "C" void kernel_launch(void* const* d_in, const int* in_sizes, int n_in, void* d_out, int out_size, void* d_ws, size_t ws_size, hipStream_t stream) {
    static int grid = 0;
    if (grid == 0) {
        if (n_in != 30 || out_size != NLAT * D || ws_size < WS_END) { fprintf(stderr, "kernel_launch: unexpected shapes (n_in %d out %d ws %zu)\n", n_in, out_size, ws_size); grid = -1; return; }
        int dev = 0, cus = 0;
        if (hipGetDevice(&dev) != hipSuccess || hipDeviceGetAttribute(&cus, hipDeviceAttributeMultiprocessorCount, dev) != hipSuccess) { grid = -1; return; }
        if (hipFuncSetAttribute((const void*)fwd_kernel, hipFuncAttributeMaxDynamicSharedMemorySize, LDS_BYTES) != hipSuccess) { fprintf(stderr, "kernel_launch: hipFuncSetAttribute failed\n"); grid = -1; return; }
        int per_cu = 0;
        if (hipOccupancyMaxActiveBlocksPerMultiprocessor(&per_cu, (const void*)fwd_kernel, 512, LDS_BYTES) != hipSuccess || per_cu < 1) fprintf(stderr, "kernel_launch: occupancy query reports %d\n", per_cu);
        (void)hipGetLastError();
        grid = cus;
        if (grid != 256) { fprintf(stderr, "kernel_launch: built for 256 CUs, got %d\n", grid); grid = -1; return; }
    }
    if (grid < 0) return;
    (void)hipMemsetAsync((char*)d_ws + WS_CTL, 0, CTL_ZERO_BYTES, stream);
    Params p{};
    for (int i = 0; i < 30; ++i) p.in[i] = (const float*)d_in[i];
    p.out = (float*)d_out; p.ws = (unsigned char*)d_ws;
    unsigned char* ws = (unsigned char*)d_ws;
    int nj = 0, items = 0; const int BIGG = 1 << 30;
    for (int l = 0; l < 2; ++l) {
        const float* win = p.in[I_WIN] + (size_t)l * D * IN_COLS; bf16_t* wt = (bf16_t*)(ws + WS_WIN) + (size_t)l * ZW * D;
        const int seg[8][3] = {{0, 0, 256}, {256, 256, 256}, {512, 512, 512}, {1024, ZGA, 16}, {1040, ZCQ, 256}, {1296, ZCKV, 128}, {1424, ZKR, 32}, {1456, ZGU, 512}};
        for (int s = 0; s < 8; ++s) add_job(p, nj, items, win, nullptr, wt, D, IN_COLS, seg[s][0], seg[s][2], seg[s][1], 0, D, BIGG, 0, 1, 0, 0, s == 1 ? 0.125f : 1.0f);
        add_job(p, nj, items, p.in[I_WOUT] + (size_t)l * D * D, nullptr, (bf16_t*)(ws + WS_WOUT) + (size_t)l * D * D, D, D, 0, D, 0, 0, D, BIGG, 0, 1, 0, 0, 1.0f);
        bf16_t* bu = (bf16_t*)(ws + WS_BUP) + (size_t)l * UPN * UPK;
        add_job(p, nj, items, p.in[I_WUQ] + (size_t)l * 256 * 768, p.in[I_CQG] + l * 256, bu, 256, 768, 0, 768, 0, 0, UPK, BIGG, 0, 1, 0, 0, 1.0f);
        add_job(p, nj, items, p.in[I_WUKV] + (size_t)l * 128 * 1024, p.in[I_CKVG] + l * 128, bu, 128, 1024, 0, 1024, 768, 256, UPK, BIGG, 0, 1, 0, 0, 1.0f);
    }
    add_job(p, nj, items, p.in[I_FW1], nullptr, (bf16_t*)(ws + WS_W13D), D, DFF, 0, DFF, 0, 0, D, 128, 256, 1, 0, 0, 1.0f, 0);
    add_job(p, nj, items, p.in[I_FW3], nullptr, (bf16_t*)(ws + WS_W13D), D, DFF, 0, DFF, 128, 0, D, 128, 256, 1, 0, 0, 1.0f, 0);
    add_job(p, nj, items, p.in[I_FW2], nullptr, (bf16_t*)(ws + WS_W2D), DFF, D, 0, D, 0, 0, DFF, BIGG, 0, 1, 0, 0, 1.0f);
    p.n_items_pro = items;
    if (nj != NJOBS_PRO) { fprintf(stderr, "job count %d\n", nj); return; }
    items = 0;
    add_job(p, nj, items, p.in[I_MW1], nullptr, (bf16_t*)(ws + WS_W13M), D, DFFE, 0, DFFE, 0, 0, D, 128, 256, NE, D * DFFE, 2 * DFFE * D, W8_SCALE, 1);
    add_job(p, nj, items, p.in[I_MW3], nullptr, (bf16_t*)(ws + WS_W13M), D, DFFE, 0, DFFE, 128, 0, D, 128, 256, NE, D * DFFE, 2 * DFFE * D, W8_SCALE, 1);
    add_job(p, nj, items, p.in[I_MW2], nullptr, (bf16_t*)(ws + WS_W2M), DFFE, D, 0, D, 0, 0, DFFE, BIGG, 0, NE, DFFE * D, D * DFFE, W28_SCALE, 1);
    p.n_items_moe = items;
#if ONE_LAUNCH
    p.ph_lo = 0; p.ph_hi = NPHASE;
    hipLaunchKernelGGL(fwd_kernel, dim3(grid), dim3(512), LDS_BYTES, stream, p);
#else
    for (int ph = 0; ph < NPHASE; ++ph) {
        if ((ph >= 11 && ph < 17) || ph == 4 || ph == 20) continue;
        p.ph_lo = ph; p.ph_hi = ph + 1;
        hipLaunchKernelGGL(fwd_kernel, dim3(grid), dim3(512), LDS_BYTES, stream, p);
#ifdef PROBE_MASK
        if ((PROBE_MASK >> ph) & 1ull) for (int r = 0; r < PROBE_REPS; ++r) hipLaunchKernelGGL(fwd_kernel, dim3(grid), dim3(512), LDS_BYTES, stream, p);
#endif
    }
#endif
}
```

```cpp
#include <hip/hip_runtime.h>
#include <cstdio>
#include <cstdint>

#define GAS __attribute__((address_space(1)))
#define LAS __attribute__((address_space(3)))
#define DI __device__ __forceinline__
typedef unsigned short bf16_t;
typedef short bf16x8 __attribute__((ext_vector_type(8)));
typedef __bf16 bf16x2_t __attribute__((ext_vector_type(2)));
typedef float f32x4 __attribute__((ext_vector_type(4)));
typedef float f32x2 __attribute__((ext_vector_type(2)));
typedef unsigned u32x4 __attribute__((ext_vector_type(4)));
typedef unsigned u32x2 __attribute__((ext_vector_type(2)));
typedef int i32x8 __attribute__((ext_vector_type(8)));
typedef int i32x4 __attribute__((ext_vector_type(4)));

#ifndef ONE_LAUNCH
#define ONE_LAUNCH 1
#endif

constexpr int D = 1024, NB = 16, SEQ = 2048, CTXL = 256;
constexpr int NLAT = NB * SEQ, NCTX = NB * CTXL, NTOK = NLAT + NCTX;
constexpr int IN_COLS = 1968;
constexpr int ZW = 2048;
constexpr int ZQA = 0, ZKA = 256, ZVA = 512, ZOA = 768, ZCQ = 1024, ZCKV = 1280, ZKR = 1408, ZGA = 1440, ZGU = 1536, ZGV = 1792;
constexpr int UPK = 384, UPN = 1792;
constexpr int DFF = 2816, DFFE = 3584, NE = 8;
constexpr int MOE_FULL = 64, MOE_SPLIT_ROW0 = (192 + MOE_FULL) * 256;
constexpr int TB = 192, MAXT = 264, NBATCH = 2;
constexpr float EPS = 1e-6f;
constexpr float H8_SCALE = 8.0f, W8_SCALE = 32.0f, G8_SCALE = 4.0f, W28_SCALE = 64.0f;
constexpr float QSCALE = 0.10206207261596577f * 1.4426950408889634f;

constexpr size_t MiB = 1u << 20;
constexpr size_t WS_CTL = 0, CTL_ZERO_BYTES = 1 * MiB;
constexpr size_t WS_MOD = 1 * MiB;
constexpr size_t WS_TOPI = 2 * MiB, WS_TOPG = WS_TOPI + 262144, WS_TOKSLOT = WS_TOPG + 262144, WS_SLOTTOK = WS_TOKSLOT + 262144;
constexpr size_t WS_GS = 2 * MiB;
constexpr size_t WS_XC = 6 * MiB;
constexpr size_t WS_WIN = 14 * MiB, WS_WOUT = 22 * MiB, WS_BUP = 26 * MiB, WS_W13D = 29 * MiB, WS_W2D = 40 * MiB, WS_WS = 46 * MiB;
constexpr size_t WS_XN = 48 * MiB;
constexpr size_t WS_BIG = 120 * MiB;
constexpr size_t WS_Z = WS_BIG, WS_QKV = 264 * MiB, WS_KF = 390 * MiB, WS_HD = 444 * MiB, WS_VLN = 482 * MiB;
constexpr size_t WS_QM = 500 * MiB;
constexpr size_t WS_G0 = WS_BIG;
constexpr size_t WS_X3 = WS_BIG, WS_Y = 184 * MiB, WS_GM = 316 * MiB;
constexpr size_t WS_P2 = 390 * MiB;
constexpr size_t WS_Y2 = 488 * MiB;
constexpr size_t WS_W13M = 503 * MiB, WS_W2M = 559 * MiB;
constexpr size_t WS_END = 587 * MiB;
static_assert(WS_VLN + (size_t)NTOK * 256 * 2 <= WS_QM && WS_QM + (size_t)NTOK * 8 * 4 <= WS_W13M && WS_GM + (size_t)TB * 256 * DFFE <= WS_W13M && WS_Y + (size_t)MAXT * 256 * D * 2 <= WS_GM && WS_X3 + (size_t)NLAT * D * 2 <= WS_Y, "ws map");
static_assert(WS_G0 + (size_t)NTOK * DFF * 2 <= WS_W13M && WS_HD + (size_t)NB * 4 * 18 * 2 * 4224 * 4 <= WS_VLN && WS_W2M + (size_t)NE * D * DFFE <= WS_END && WS_W13M + (size_t)NE * 2 * DFFE * D <= WS_W2M && WS_Z + (size_t)NTOK * ZW * 2 <= WS_QKV && WS_QKV + (size_t)NTOK * UPN * 2 <= WS_KF && WS_KF + (size_t)NTOK * 768 * 2 <= WS_HD, "ws map 2");
constexpr int CW_BAR = 4096;
constexpr int CW_NT = 16384;
constexpr int CW_TEXP = 16448;
constexpr int CW_BCNT = 32768;

constexpr int LDS_BYTES = 147456, LDSCTL_OFF = 131072;

DI float bf2f(unsigned short b) { return __uint_as_float((unsigned)b << 16); }
DI unsigned f2bf(float f) { unsigned u = __float_as_uint(f); return (u + 0x7fffu + ((u >> 16) & 1u)) >> 16; }
DI unsigned pk2(float lo, float hi) { unsigned r; asm("v_cvt_pk_bf16_f32 %0, %1, %2" : "=v"(r) : "v"(lo), "v"(hi)); return r; }
DI float lo_f(unsigned w) { return __uint_as_float(w << 16); }
DI float hi_f(unsigned w) { return __uint_as_float(w & 0xffff0000u); }
DI float wave_sum(float v) {
#pragma unroll
    for (int o = 1; o < 64; o <<= 1) v += __shfl_xor(v, o);
    return v;
}
DI int wave_sum_i(int v) {
#pragma unroll
    for (int o = 1; o < 64; o <<= 1) v += __shfl_xor(v, o);
    return v;
}
DI float wave_max(float v) {
#pragma unroll
    for (int o = 1; o < 64; o <<= 1) v = fmaxf(v, __shfl_xor(v, o));
    return v;
}
DI float sigmoidf_(float x) { return __builtin_amdgcn_rcpf(1.0f + __expf(-x)); }
DI float gelu_tanh(float x) { const float x2 = x * x; return x * __builtin_amdgcn_rcpf(1.0f + __builtin_amdgcn_exp2f(x * __builtin_fmaf(x2, -0.10294324f, -2.3022082f))); }
DI float log_sigmoid(float x) { return fminf(x, 0.f) - log1pf(__expf(-fabsf(x))); }

DI int opq_lane() { int x; asm volatile("v_mbcnt_lo_u32_b32 %0, -1, 0\n\tv_mbcnt_hi_u32_b32 %0, -1, %0" : "=v"(x)); return x; }
DI int opq_i(int i) { i = __builtin_amdgcn_readfirstlane(i); asm volatile("" : "+s"(i)); return i; }
DI GAS unsigned char* opq_p(unsigned char* p) { unsigned long long v = (unsigned long long)p; const unsigned lo_ = __builtin_amdgcn_readfirstlane((unsigned)v), hi_ = __builtin_amdgcn_readfirstlane((unsigned)(v >> 32));
    v = ((unsigned long long)hi_ << 32) | lo_; asm volatile("" : "+s"(v)); GAS unsigned char* q = (GAS unsigned char*)v;
    return q; }

#define XB_TMO      128
#define XB_XCNT(j)  (256  + 64 * (j))
#define XB_XSUB(j)  (1280 + 64 * (j))
#define XB_XGEN(j)  (2304 + 64 * (j))
#define XB_TOP      3328
#define XB_TOPGEN   3392
#define XCD_BAR_WORDS 3456
#define XB_SPIN_CAP (1u << 18)
DI unsigned xb_ld(unsigned* p)              { return __hip_atomic_load(p, __ATOMIC_RELAXED, __HIP_MEMORY_SCOPE_AGENT); }
DI unsigned xb_add(unsigned* p, unsigned v) { return __hip_atomic_fetch_add(p, v, __ATOMIC_RELAXED, __HIP_MEMORY_SCOPE_AGENT); }
DI unsigned xb_xcc_id() { return (unsigned)__builtin_amdgcn_s_getreg((3 << 11) | 20) & 0xFu; }
#define XB_SPIN(cond, bar) do { unsigned _sp = 0; while (cond) { __builtin_amdgcn_s_sleep(1); \
    if ((++_sp & 255u) == 0u) { if (xb_ld(&(bar)[XB_TMO])) break; if (_sp > XB_SPIN_CAP) { atomicAdd(&(bar)[XB_TMO], 1u); break; } } } } while (0)
struct XcdBarrier { unsigned* bar; unsigned x; volatile LAS unsigned* st; };
DI XcdBarrier xcd_barrier_post(unsigned* bar, volatile LAS unsigned* st) {
    XcdBarrier b; b.bar = bar; b.x = xb_xcc_id(); b.st = st;
    if (threadIdx.x == 0) (void)xb_add(&bar[XB_XCNT(b.x)], 1u);
    return b;
}
DI void xcd_barrier_complete(unsigned* bar, unsigned x, unsigned& nloc, unsigned& nx) {
    const unsigned G = gridDim.x * gridDim.y * gridDim.z;
    unsigned sum, cnt, mine, sp = 0u;
    for (;;) {
        sum = 0u; cnt = 0u; mine = 0u;
#pragma unroll
        for (unsigned j = 0; j < 16; ++j) { const unsigned c = xb_ld(&bar[XB_XCNT(j)]); sum += c; cnt += (c > 0u) ? 1u : 0u; mine = (j == x) ? c : mine; }
        if (sum == G) break;
        __builtin_amdgcn_s_sleep(1);
        if ((++sp & 255u) == 0u) { if (xb_ld(&bar[XB_TMO])) break; if (sp > XB_SPIN_CAP) { atomicAdd(&bar[XB_TMO], 1u); break; } }
    }
    nloc = mine > 0u ? mine : 1u; nx = cnt > 0u ? cnt : 1u;
}
DI void xcd_barrier(const XcdBarrier& b) {
    asm volatile("s_waitcnt vmcnt(0)" ::: "memory");
    __syncthreads();
    if (threadIdx.x == 0) {
        unsigned* bar = b.bar;
        __builtin_amdgcn_s_waitcnt(0);
        unsigned nloc = b.st[0], nx = b.st[1];
        if (nloc == 0u) { xcd_barrier_complete(bar, b.x, nloc, nx); b.st[0] = nloc; b.st[1] = nx; }
        const unsigned old = xb_add(&bar[XB_XSUB(b.x)], 1u);
        const unsigned gen = old / nloc;
        if (old + 1u == (gen + 1u) * nloc) {
            __builtin_amdgcn_fence(__ATOMIC_RELEASE, "agent");
            asm volatile("s_waitcnt vmcnt(0)" ::: "memory");
            const unsigned og = xb_add(&bar[XB_TOP], 1u);
            const unsigned tg = og / nx;
            if (og + 1u != (tg + 1u) * nx) XB_SPIN(xb_ld(&bar[XB_TOP]) < (tg + 1u) * nx, bar);
            __builtin_amdgcn_fence(__ATOMIC_ACQUIRE, "agent");
            asm volatile("s_waitcnt vmcnt(0)" ::: "memory");
        } else {
            XB_SPIN(xb_ld(&bar[XB_TOP]) < (gen + 1u) * nx, bar);
            __builtin_amdgcn_fence(__ATOMIC_ACQUIRE, "agent");
            asm volatile("s_waitcnt vmcnt(0)" ::: "memory");
        }
    }
    __syncthreads();
}

namespace pg8 {
constexpr int BM = 256, BK = 64, HALF = 128, HTB = HALF * BK * 2, STAGE_BYTES = 8 * HTB, NXCD = 8, WGM = 8;
__host__ __device__ __forceinline__ int lds_byte(int r, int c) { const int st = (r >> 4) * 2 + (c >> 5), rr = r & 15, cc = c & 31, ob = rr * 64 + cc * 2; return st * 1024 + (ob ^ (((ob >> 9) & 1) << 5)); }
__host__ __device__ __forceinline__ void stage_rc(int b, int& R, int& C) { const int st = b / 1024, sb = b % 1024, swz = sb ^ (((sb >> 9) & 1) << 5); R = (st >> 1) * 16 + swz / 64; C = (st & 1) * 32 + (swz % 64) / 2; }
__host__ __device__ __forceinline__ int perm32(int rho) { const int n = rho >> 4, i = rho & 15; return 8 * (i >> 2) + 4 * n + (i & 3); }

struct Unit { int pm, pn, pb, kofs, nt; };
struct Gemm { const GAS bf16_t* A; const GAS bf16_t* Bt; int K, lda; const GAS int* rowidx; };

struct StaticOrder {
    static constexpr bool VARK = false, SSQ = false;
    int nM, nN, nwg, G, c;
    DI void init(int M, int N, int G_, int c_) { nM = M / BM; nN = N / BM; nwg = nM * nN; G = G_; c = c_; }
    DI bool next(int i, Unit& u) const {
        const long L = (long)i * G + c; if (L >= nwg) return false;
        int wgid = (int)L; { const int q = nwg / NXCD, r = nwg % NXCD, xcd = wgid % NXCD, off = wgid / NXCD; wgid = (xcd < r ? xcd * (q + 1) : r * (q + 1) + (xcd - r) * q) + off; }
        const int nig = WGM * nN, gid = wgid / nig, fm = gid * WGM, gsz = (nM - fm) < WGM ? (nM - fm) : WGM;
        u.pm = fm + ((wgid % nig) % gsz); u.pn = (wgid % nig) / gsz; u.pb = u.pn; return true;
    }
};
struct MoeOrder {
    static constexpr bool VARK = false, SSQ = false;
    int t0, nT, nN, G, c; int tb[7];
    DI bool next(int i, Unit& u) const {
        const int nwg = nT * nN; const long L = (long)i * G + c; if (L >= nwg) return false;
        int w = (int)L; { const int q = nwg / NXCD, r = nwg % NXCD, xcd = w % NXCD, off = w / NXCD; w = (xcd < r ? xcd * (q + 1) : r * (q + 1) + (xcd - r) * q) + off; }
        const int nig = WGM * nN, gid = w / nig, fm = gid * WGM, gsz = (nT - fm) < WGM ? (nT - fm) : WGM;
        u.pm = t0 + fm + ((w % nig) % gsz); u.pn = (w % nig) / gsz;
        int e = 0;
#pragma unroll
        for (int x = 0; x < 7; ++x) e += (u.pm >= tb[x]) ? 1 : 0;
        u.pb = e * nN + u.pn; return true;
    }
};

struct Ffn2Order {
    static constexpr bool VARK = true, SSQ = false;
    int G, c, ntfull;
    DI bool next(int i, Unit& u) const {
        const long L = (long)i * G + c; if (L >= 512 + 128) return false;
        const bool sp = L >= 512;
        int w = sp ? 0 : (int)L; { const int xcd = w % NXCD, off = w / NXCD; w = xcd * 64 + off; }
        const int nig = WGM * 4, gid = w / nig, fm = gid * WGM;
        const int pm1 = fm + ((w % nig) % WGM), pn1 = (w % nig) / WGM;
        const int L2 = sp ? (int)L - 512 : 0; const int pm2 = 128 + L2 / 8, pn2 = (L2 % 8) >> 1;
        u.pm = sp ? pm2 : pm1; u.pn = sp ? pn2 : pn1; u.pb = u.pn; u.nt = sp ? ntfull / 2 : ntfull; u.kofs = sp ? (L2 & 1) * (ntfull / 2) * 64 : 0;
        return true;
    }
};
struct MoeSplitOrder {
    static constexpr bool VARK = true, SSQ = false;
    int t0, n1, n2, nN, G, c, ntfull; int tb[7];
    DI bool next(int i, Unit& u) const {
        const int nwg1 = n1 * nN, nwg2 = n2 * nN * 2; const long L = (long)i * G + c; if (L >= nwg1 + nwg2) return false;
        const bool sp = L >= nwg1; const int nwg1s = nwg1 > 0 ? nwg1 : 1;
        int w = sp ? 0 : (int)L; { const int q = nwg1s / NXCD, r = nwg1s % NXCD, xcd = w % NXCD, off = w / NXCD; w = (xcd < r ? xcd * (q + 1) : r * (q + 1) + (xcd - r) * q) + off; }
        const int nig = WGM * nN, gid = w / nig, fm = gid * WGM, gsz0 = (n1 - fm) < WGM ? (n1 - fm) : WGM, gsz = gsz0 > 0 ? gsz0 : 1;
        const int pm1 = t0 + fm + ((w % nig) % gsz), pn1 = (w % nig) / gsz;
        const int L2 = sp ? (int)L - nwg1 : 0; const int pm2 = t0 + n1 + L2 / (2 * nN), pn2 = (L2 % (2 * nN)) >> 1;
        u.pm = sp ? pm2 : pm1; u.pn = sp ? pn2 : pn1; u.nt = sp ? ntfull / 2 : ntfull; u.kofs = sp ? (L2 & 1) * (ntfull / 2) * 128 : 0;
        int e = 0;
#pragma unroll
        for (int x = 0; x < 7; ++x) e += (u.pm >= tb[x]) ? 1 : 0;
        u.pb = e * nN + u.pn; return true;
    }
};

struct UpOrder {
    static constexpr bool VARK = true, SSQ = true;
    int G, c;
    DI bool next(int i, Unit& u) const {
        const long L = (long)i * G + c; if (L >= 1008) return false;
        const int xcd = (int)L % NXCD, off = (int)L / NXCD;
        if (off < 54) { const int w = 54 * xcd + off, gid = w / 24, r = w % 24; u.pm = 8 * gid + (r & 7); u.pn = r >> 3; u.kofs = 0; u.nt = 4; }
        else { const int w = 72 * xcd + (off - 54), gid = w >> 5, r = w & 31; u.pm = 8 * gid + (r & 7); u.pn = 3 + (r >> 3); u.kofs = 256; u.nt = 2; }
        u.pb = u.pn; return true;
    }
};

DI unsigned cvt_pk_bf16(float lo, float hi) { unsigned r; asm volatile("v_cvt_pk_bf16_f32 %0, %1, %2" : "=v"(r) : "v"(lo), "v"(hi)); return r; }

struct EpiBf16 {
    static constexpr bool PERM = true;
    GAS bf16_t* O; int ldc; float oscale;
    DI void operator()(const f32x4 (&acc)[2][2][4][2], const Unit& u, int wr, int wc, int fr, int fq) const {
        const int row0 = u.pm * BM + wr * 64 + fr, col0 = u.pn * BM + wc * 32 + 8 * fq;
#pragma unroll
        for (int ai = 0; ai < 2; ++ai)
#pragma unroll
            for (int m = 0; m < 4; ++m) { auto rowp = O + (size_t)(row0 + ai * HALF + m * 16) * ldc + col0;
#pragma unroll
                for (int bj = 0; bj < 2; ++bj) { f32x4 v0 = acc[ai][bj][m][0], v1 = acc[ai][bj][m][1]; if (oscale != 1.0f) { v0 *= oscale; v1 *= oscale; }
                    u32x4 w; w.x = cvt_pk_bf16(v0[0], v0[1]); w.y = cvt_pk_bf16(v0[2], v0[3]); w.z = cvt_pk_bf16(v1[0], v1[1]); w.w = cvt_pk_bf16(v1[2], v1[3]);
                    *(GAS u32x4*)(rowp + bj * HALF) = w; } }
    }
};
struct EpiBf16S {
    static constexpr bool PERM = true;
    GAS bf16_t* O; GAS bf16_t* O2; int ldc; float oscale; int row2_0;
    DI void operator()(const f32x4 (&acc)[2][2][4][2], const Unit& u, int wr, int wc, int fr, int fq) const {
        const int row0 = u.pm * BM + wr * 64 + fr, col0 = u.pn * BM + wc * 32 + 8 * fq;
        auto base = u.kofs != 0 ? O2 - (size_t)row2_0 * ldc : O;
#pragma unroll
        for (int ai = 0; ai < 2; ++ai)
#pragma unroll
            for (int m = 0; m < 4; ++m) { auto rowp = base + (size_t)(row0 + ai * HALF + m * 16) * ldc + col0;
#pragma unroll
                for (int bj = 0; bj < 2; ++bj) { const f32x4 v0 = acc[ai][bj][m][0] * oscale, v1 = acc[ai][bj][m][1] * oscale;
                    u32x4 w; w.x = cvt_pk_bf16(v0[0], v0[1]); w.y = cvt_pk_bf16(v0[2], v0[3]); w.z = cvt_pk_bf16(v1[0], v1[1]); w.w = cvt_pk_bf16(v1[2], v1[3]);
                    *(GAS u32x4*)(rowp + bj * HALF) = w; } }
    }
};
template <bool OUT8> struct EpiSwigluT {
    static constexpr bool PERM = true;
    GAS bf16_t* O; int ldc; int tile0; float oscale;
    DI void operator()(const f32x4 (&acc)[2][2][4][2], const Unit& u, int wr, int wc, int fr, int fq) const {
        const int row0 = (u.pm - tile0) * BM + wr * 64 + fr, col0 = u.pn * HALF + wc * 32 + 8 * fq;
        const float ka = -1.4426950408889634f * oscale, ikc = 1.0f / (oscale * oscale * (OUT8 ? G8_SCALE : 1.0f));
#pragma unroll
        for (int ai = 0; ai < 2; ++ai)
#pragma unroll
            for (int m = 0; m < 4; ++m) { auto rowp = O + (size_t)(row0 + ai * HALF + m * 16) * ldc + col0;
                float o[8];
#pragma unroll
                for (int n = 0; n < 2; ++n)
#pragma unroll
                    for (int j = 0; j < 4; ++j) { const float a = acc[ai][0][m][n][j], b = acc[ai][1][m][n][j];
                        o[n * 4 + j] = (a * b) * __builtin_amdgcn_rcpf(__builtin_fmaf(__builtin_amdgcn_exp2f(ka * a), ikc, ikc)); }
                if constexpr (OUT8) { int w0 = __builtin_amdgcn_cvt_pk_fp8_f32(o[0], o[1], 0, false); w0 = __builtin_amdgcn_cvt_pk_fp8_f32(o[2], o[3], w0, true);
                    int w1 = __builtin_amdgcn_cvt_pk_fp8_f32(o[4], o[5], 0, false); w1 = __builtin_amdgcn_cvt_pk_fp8_f32(o[6], o[7], w1, true);
                    u32x2 w; w.x = (unsigned)w0; w.y = (unsigned)w1; *(GAS u32x2*)((GAS unsigned char*)O + (size_t)(row0 + ai * HALF + m * 16) * ldc + col0) = w; }
                else { u32x4 w; w.x = cvt_pk_bf16(o[0], o[1]); w.y = cvt_pk_bf16(o[2], o[3]); w.z = cvt_pk_bf16(o[4], o[5]); w.w = cvt_pk_bf16(o[6], o[7]);
                    *(GAS u32x4*)rowp = w; } }
    }
};
typedef EpiSwigluT<false> EpiSwiglu;
typedef EpiSwigluT<true> EpiSwiglu8;
template <bool BASE32> struct EpiResidT {
    static constexpr bool PERM = true;
    const GAS void* base_lat; const GAS void* base_ctx; GAS bf16_t* out_lat; GAS bf16_t* out_ctx; const GAS float* modl; int goff;
    DI void operator()(const f32x4 (&acc)[2][2][4][2], const Unit& u, int wr, int wc, int fr, int fq) const {
        const int trow = u.pm * BM; const bool lat = trow < NLAT; const int midx = lat ? (trow >> 11) : 16;
        const size_t rbase = lat ? (size_t)trow * D : (size_t)(trow - NLAT) * D;
        auto base = lat ? base_lat : base_ctx; auto out = (lat ? out_lat : out_ctx) + rbase;
        auto gate = modl + (size_t)midx * 6144 + goff;
        const int col0 = u.pn * BM + wc * 32 + 8 * fq, r0 = wr * 64 + fr;
        f32x4 gv[2][2];
#pragma unroll
        for (int bj = 0; bj < 2; ++bj)
#pragma unroll
            for (int n = 0; n < 2; ++n) gv[bj][n] = *(const GAS f32x4*)(gate + col0 + bj * HALF + 4 * n);
        constexpr int MB = BASE32 ? 2 : 4;
#pragma unroll
        for (int ab = 0; ab < 8 / MB; ++ab) {
            f32x4 b32[8][2][2]; u32x4 b16[8][2];
#pragma unroll
            for (int q = 0; q < MB; ++q) { const int ai = (ab * MB + q) >> 2, m = (ab * MB + q) & 3; const size_t off = (size_t)(r0 + ai * HALF + m * 16) * D + col0;
#pragma unroll
                for (int bj = 0; bj < 2; ++bj) {
                    if constexpr (BASE32) { b32[q][bj][0] = *(const GAS f32x4*)((const GAS float*)base + rbase + off + bj * HALF); b32[q][bj][1] = *(const GAS f32x4*)((const GAS float*)base + rbase + off + bj * HALF + 4); }
                    else b16[q][bj] = *(const GAS u32x4*)((const GAS bf16_t*)base + rbase + off + bj * HALF); } }
#pragma unroll
            for (int q = 0; q < MB; ++q) { const int ai = (ab * MB + q) >> 2, m = (ab * MB + q) & 3; const size_t off = (size_t)(r0 + ai * HALF + m * 16) * D + col0;
#pragma unroll
                for (int bj = 0; bj < 2; ++bj) { f32x4 s0, s1;
                    if constexpr (BASE32) { s0 = b32[q][bj][0]; s1 = b32[q][bj][1]; }
                    else { const u32x4 bw = b16[q][bj]; s0 = (f32x4){lo_f(bw.x), hi_f(bw.x), lo_f(bw.y), hi_f(bw.y)}; s1 = (f32x4){lo_f(bw.z), hi_f(bw.z), lo_f(bw.w), hi_f(bw.w)}; }
                    const f32x4 o0 = s0 + gv[bj][0] * acc[ai][bj][m][0], o1 = s1 + gv[bj][1] * acc[ai][bj][m][1];
                    u32x4 w; w.x = cvt_pk_bf16(o0[0], o0[1]); w.y = cvt_pk_bf16(o0[2], o0[3]); w.z = cvt_pk_bf16(o1[0], o1[1]); w.w = cvt_pk_bf16(o1[2], o1[3]);
                    *(GAS u32x4*)(out + off + bj * HALF) = w; } }
        }
    }
};

struct EpiResidS {
    static constexpr bool PERM = true;
    EpiResidT<false> R; GAS bf16_t* P2;
    DI void operator()(const f32x4 (&acc)[2][2][4][2], const Unit& u, int wr, int wc, int fr, int fq) const {
        if (u.kofs == 0) { R(acc, u, wr, wc, fr, fq); return; }
        const int trow = u.pm * BM;
        auto gate = R.modl + (size_t)16 * 6144 + R.goff;
        const int col0 = u.pn * BM + wc * 32 + 8 * fq, r0 = wr * 64 + fr;
        f32x4 gv[2][2];
#pragma unroll
        for (int bj = 0; bj < 2; ++bj)
#pragma unroll
            for (int n = 0; n < 2; ++n) gv[bj][n] = *(const GAS f32x4*)(gate + col0 + bj * HALF + 4 * n);
#pragma unroll
        for (int ai = 0; ai < 2; ++ai)
#pragma unroll
            for (int m = 0; m < 4; ++m) { const size_t off = (size_t)(trow - NLAT + r0 + ai * HALF + m * 16) * D + col0;
#pragma unroll
                for (int bj = 0; bj < 2; ++bj) { const f32x4 o0 = gv[bj][0] * acc[ai][bj][m][0], o1 = gv[bj][1] * acc[ai][bj][m][1];
                    u32x4 w; w.x = cvt_pk_bf16(o0[0], o0[1]); w.y = cvt_pk_bf16(o0[2], o0[3]); w.z = cvt_pk_bf16(o1[0], o1[1]); w.w = cvt_pk_bf16(o1[2], o1[3]);
                    *(GAS u32x4*)(P2 + off + bj * HALF) = w; } }
    }
};
template <class Epi, class Sched, bool GATHER, bool FP8 = false>
DI void gemm_phase(LAS unsigned char* lds, const Gemm g, const Sched& S, const Epi& E, const int tid) {
    const int wid = __builtin_amdgcn_readfirstlane(tid >> 6), lane = tid & 63, wr = wid >> 2, wc = wid & 3, fr = lane & 15, fq = lane >> 4;
    const int Kb = FP8 ? g.K : 2 * g.K, ldab = FP8 ? g.lda : 2 * g.lda, nt = Kb / 128;
    int R0, C0; stage_rc(tid * 16, R0, C0);
    const int Rb = Epi::PERM ? ((R0 & ~31) + perm32(R0 & 31)) : R0;
    const unsigned voffB = (unsigned)(Rb * Kb + 2 * C0), voffA = (unsigned)(R0 * ldab + 2 * C0);
    const size_t kstep = (size_t)(BK * 2);
    const size_t hstepB = (size_t)HALF * Kb, tstepB = 2 * hstepB, r64B = (size_t)64 * Kb;
    const size_t hstepA = (size_t)HALF * ldab, tstepA = 2 * hstepA, r64A = (size_t)64 * ldab;
    const unsigned ldsw = (unsigned)wid * 1024u;
    const int aoff = lds_byte(wr * 64 + fr, fq * 8), boff = lds_byte(wc * 32 + fr, fq * 8);
    const __amdgpu_buffer_rsrc_t rsA = __builtin_amdgcn_make_buffer_rsrc((GAS void*)g.A, 0, 0x7ffffffc, 0x00020000), rsB = __builtin_amdgcn_make_buffer_rsrc((GAS void*)g.Bt, 0, 0x7ffffffc, 0x00020000);
#define PG8_SA(b, h) (((b) * 2 + (h)) * HTB)
#define PG8_SB(b, h) ((4 + (b) * 2 + (h)) * HTB)
#define PG8_BLDS(rs, vo, so, loff) __builtin_amdgcn_raw_ptr_buffer_load_lds((rs), (LAS void*)(lds + (loff)), 16, (int)(vo), __builtin_amdgcn_readfirstlane((int)(so)), 0, 0)
#define PG8_STAGE_B(bufoff, gbase) do { PG8_BLDS(rsB, voffB, (gbase), (bufoff) + ldsw); PG8_BLDS(rsB, voffB, (gbase) + r64B, (bufoff) + ldsw + 8192); } while (0)
#define PG8_STAGE_A(bufoff, ubase, kb, vo) do { if constexpr (GATHER) { PG8_BLDS(rsA, (vo)[0], (kb), (bufoff) + ldsw); PG8_BLDS(rsA, (vo)[1], (kb), (bufoff) + ldsw + 8192); } \
        else { PG8_BLDS(rsA, voffA, (ubase) + (kb), (bufoff) + ldsw); PG8_BLDS(rsA, voffA, (ubase) + (kb) + r64A, (bufoff) + ldsw + 8192); } } while (0)
#define PG8_GOFF(u, h, i) ((unsigned)(g.rowidx[(u).pm * BM + (h) * HALF + R0 + (i) * 64] * ldab + 2 * C0))
#define PG8_LD8(p) __builtin_shufflevector(*(const LAS i32x4*)(p), *(const LAS i32x4*)((p) + 1024), 0, 1, 2, 3, 4, 5, 6, 7)
#define PG8_LDA(dst, b, h) do { if constexpr (FP8) { _Pragma("unroll") for (int m = 0; m < 4; ++m) dst##8[m] = PG8_LD8(lds + PG8_SA(b, h) + aoff + m * 2048); } \
        else { _Pragma("unroll") for (int m = 0; m < 4; ++m) _Pragma("unroll") for (int k = 0; k < 2; ++k) dst[m][k] = *(const LAS bf16x8*)(lds + PG8_SA(b, h) + aoff + m * 2048 + k * 1024); } } while (0)
#define PG8_LDB(dst, b, h) do { if constexpr (FP8) { _Pragma("unroll") for (int n = 0; n < 2; ++n) dst##8[n] = PG8_LD8(lds + PG8_SB(b, h) + boff + n * 2048); } \
        else { _Pragma("unroll") for (int n = 0; n < 2; ++n) _Pragma("unroll") for (int k = 0; k < 2; ++k) dst[n][k] = *(const LAS bf16x8*)(lds + PG8_SB(b, h) + boff + n * 2048 + k * 1024); } } while (0)
#define PG8_MMA(ai, bj, At, Bt) do { __builtin_amdgcn_s_setprio(1); if constexpr (FP8) { _Pragma("unroll") for (int m = 0; m < 4; ++m) _Pragma("unroll") for (int n = 0; n < 2; ++n) \
        asm volatile("v_mfma_f32_16x16x128_f8f6f4 %0, %1, %2, %0" : "+v"(acc[ai][bj][m][n]) : "v"(Bt##8[n]), "v"(At##8[m])); }     \
        else { _Pragma("unroll") for (int m = 0; m < 4; ++m) _Pragma("unroll") for (int n = 0; n < 2; ++n) _Pragma("unroll") for (int k = 0; k < 2; ++k) \
        acc[ai][bj][m][n] = __builtin_amdgcn_mfma_f32_16x16x32_bf16(Bt[n][k], At[m][k], acc[ai][bj][m][n], 0, 0, 0); } __builtin_amdgcn_s_setprio(0); } while (0)
#define PG8_SSQ1(h, m) do { _Pragma("unroll") for (int k = 0; k < 2; ++k) { const u32x4 w_ = __builtin_bit_cast(u32x4, At[m][k]); \
        _Pragma("unroll") for (int e = 0; e < 4; ++e) { const bf16x2_t p_ = __builtin_bit_cast(bf16x2_t, w_[e]); ssq[h] = __builtin_amdgcn_fdot2_f32_bf16(p_, p_, ssq[h], false); } } } while (0)
#define PG8_SSQ(h) do { if constexpr (Sched::SSQ) { if (wc == 0) PG8_SSQ1(h, 0); else if (wc == 1) PG8_SSQ1(h, 1); else if (wc == 2) PG8_SSQ1(h, 2); else PG8_SSQ1(h, 3); } } while (0)
#define PG8_WAIT_V(n) asm volatile("s_waitcnt vmcnt(" #n ")" ::: "memory")
#define PG8_WAIT_L(n) asm volatile("s_waitcnt lgkmcnt(" #n ")" ::: "memory")
#define PG8_BAR __builtin_amdgcn_s_barrier()
#define PG8_SCHED __builtin_amdgcn_sched_barrier(0)
    Unit cur, nxt; int ui = 0;
    if (!S.next(0, cur)) return;
    f32x4 acc[2][2][4][2];
#pragma unroll
    for (int a = 0; a < 2; ++a)
#pragma unroll
        for (int b = 0; b < 2; ++b)
#pragma unroll
            for (int m = 0; m < 4; ++m)
#pragma unroll
                for (int n = 0; n < 2; ++n) acc[a][b][m][n] = (f32x4){0.f, 0.f, 0.f, 0.f};
    bf16x8 At[4][2], B0[2][2], B1[2][2]; i32x8 At8[4], B08[2], B18[2];
    float ssq[2] = {0.f, 0.f};
    LAS float* XS = (LAS float*)(lds + LDSCTL_OFF + 4096);
    unsigned va0[2] = {0u, 0u}, va1[2] = {0u, 0u};
    if constexpr (GATHER) { va0[0] = PG8_GOFF(cur, 0, 0); va0[1] = PG8_GOFF(cur, 0, 1); va1[0] = PG8_GOFF(cur, 1, 0); va1[1] = PG8_GOFF(cur, 1, 1); }
    unsigned cA = (unsigned)((size_t)cur.pm * tstepA), cB = (unsigned)((size_t)cur.pb * tstepB);
    if constexpr (Sched::VARK) { cA += (FP8 ? 1u : 2u) * (unsigned)cur.kofs; cB += (FP8 ? 1u : 2u) * (unsigned)cur.kofs; }
    PG8_STAGE_B(PG8_SB(0, 0), cB); PG8_STAGE_A(PG8_SA(0, 0), cA, 0, va0); PG8_STAGE_B(PG8_SB(0, 1), cB + hstepB); PG8_STAGE_A(PG8_SA(0, 1), cA + hstepA, 0, va1);
    if (wr == 1) PG8_BAR;
    PG8_WAIT_V(4); PG8_BAR;
    PG8_STAGE_B(PG8_SB(1, 0), cB + kstep); PG8_STAGE_A(PG8_SA(1, 0), cA, kstep, va0); PG8_STAGE_B(PG8_SB(1, 1), cB + hstepB + kstep);
    PG8_WAIT_V(6); PG8_BAR;
    for (;;) {
        const bool has_next = S.next(ui + 1, nxt);
        unsigned nA = has_next ? (unsigned)((size_t)nxt.pm * tstepA) : cA, nB = has_next ? (unsigned)((size_t)nxt.pb * tstepB) : cB;
        if constexpr (Sched::VARK) { if (has_next) { nA += (FP8 ? 1u : 2u) * (unsigned)nxt.kofs; nB += (FP8 ? 1u : 2u) * (unsigned)nxt.kofs; } }
        const int ntc = Sched::VARK ? cur.nt : nt;
        int vi[4] = {0, 0, 0, 0};
        if constexpr (GATHER) { if (has_next) { vi[0] = g.rowidx[nxt.pm * BM + R0]; vi[1] = g.rowidx[nxt.pm * BM + R0 + 64]; vi[2] = g.rowidx[nxt.pm * BM + HALF + R0]; vi[3] = g.rowidx[nxt.pm * BM + HALF + R0 + 64]; } }
#pragma unroll 1
        for (int t = 0; t < ntc; t += 2) {
            const bool last = (t == ntc - 2);
            const size_t k1 = (size_t)(t + 1) * kstep;
            const size_t k2 = last ? 0 : (size_t)(t + 2) * kstep, k3 = k2 + kstep;
            const unsigned a2 = last ? nA : cA; const unsigned b2 = last ? nB : cB + (unsigned)((t + 2) * kstep); const unsigned b3 = b2 + (unsigned)kstep;
            if constexpr (GATHER) { if (last && has_next) { va0[0] = (unsigned)(vi[0] * ldab + 2 * C0); va0[1] = (unsigned)(vi[1] * ldab + 2 * C0); } }
            PG8_LDB(B0, 0, 0); PG8_SCHED; PG8_LDA(At, 0, 0); PG8_STAGE_A(PG8_SA(1, 1), cA + hstepA, k1, va1);
            if constexpr (GATHER) { if (last && has_next) { va1[0] = (unsigned)(vi[2] * ldab + 2 * C0); va1[1] = (unsigned)(vi[3] * ldab + 2 * C0); } }
            PG8_WAIT_L(8); PG8_BAR; PG8_WAIT_L(0); PG8_MMA(0, 0, At, B0); PG8_SSQ(0); PG8_BAR; PG8_SCHED;
            PG8_LDB(B1, 0, 1); PG8_STAGE_B(PG8_SB(0, 0), b2);
            PG8_BAR; PG8_WAIT_L(0); PG8_MMA(0, 1, At, B1); PG8_BAR;
            PG8_LDA(At, 0, 1); PG8_STAGE_A(PG8_SA(0, 0), a2, k2, va0);
            PG8_BAR; PG8_WAIT_L(0); PG8_MMA(1, 0, At, B0); PG8_SSQ(1); PG8_BAR; PG8_SCHED;
            PG8_STAGE_B(PG8_SB(0, 1), b2 + hstepB);
            PG8_WAIT_V(6); PG8_BAR; PG8_MMA(1, 1, At, B1); PG8_BAR;
            PG8_LDB(B0, 1, 0); PG8_SCHED; PG8_LDA(At, 1, 0); PG8_STAGE_A(PG8_SA(0, 1), a2 + hstepA, k2, va1);
            PG8_WAIT_L(8); PG8_BAR; PG8_WAIT_L(0); PG8_MMA(0, 0, At, B0); PG8_SSQ(0); PG8_BAR; PG8_SCHED;
            PG8_LDB(B1, 1, 1); PG8_STAGE_B(PG8_SB(1, 0), b3);
            PG8_BAR; PG8_WAIT_L(0); PG8_MMA(0, 1, At, B1); PG8_BAR;
            PG8_LDA(At, 1, 1); PG8_STAGE_A(PG8_SA(1, 0), a2, k3, va0);
            PG8_BAR; PG8_WAIT_L(0); PG8_MMA(1, 0, At, B0); PG8_SSQ(1); PG8_BAR; PG8_SCHED;
            PG8_STAGE_B(PG8_SB(1, 1), b3 + hstepB);
            PG8_WAIT_V(6); PG8_BAR; PG8_MMA(1, 1, At, B1); PG8_BAR;
        }
        if constexpr (FP8) asm volatile("s_nop 15\n\ts_nop 7" : "+v"(acc[1][1][0][0]), "+v"(acc[1][1][0][1]), "+v"(acc[1][1][1][0]), "+v"(acc[1][1][1][1]), "+v"(acc[1][1][2][0]), "+v"(acc[1][1][2][1]), "+v"(acc[1][1][3][0]), "+v"(acc[1][1][3][1]));
        if constexpr (Sched::SSQ) {
#pragma unroll
            for (int a = 0; a < 2; ++a) { float t_ = ssq[a]; t_ += __shfl_xor(t_, 16); t_ += __shfl_xor(t_, 32); ssq[a] = 0.f; if (fq == 0) XS[((wr * 2 + a) * 4 + wc) * 16 + fr] = t_; }
            PG8_WAIT_L(0); PG8_BAR;
#pragma unroll
            for (int a = 0; a < 2; ++a)
#pragma unroll
                for (int m = 0; m < 4; ++m) { const float t_ = XS[((wr * 2 + a) * 4 + m) * 16 + fr]; const float r_ = __builtin_amdgcn_rsqf(t_ * (ntc == 4 ? 1.0f / 256.0f : 1.0f / 128.0f) + EPS);
#pragma unroll
                    for (int b = 0; b < 2; ++b)
#pragma unroll
                        for (int n = 0; n < 2; ++n) acc[a][b][m][n] *= r_; }
        }
        E(acc, cur, wr, wc, fr, fq);
        if (!has_next) break;
#pragma unroll
        for (int a = 0; a < 2; ++a)
#pragma unroll
            for (int b = 0; b < 2; ++b)
#pragma unroll
                for (int m = 0; m < 4; ++m)
#pragma unroll
                    for (int n = 0; n < 2; ++n) acc[a][b][m][n] = (f32x4){0.f, 0.f, 0.f, 0.f};
        cur = nxt; cA = nA; cB = nB; ++ui;
    }
    PG8_WAIT_V(0);
    if (wr == 0) PG8_BAR;
    PG8_BAR;
#undef PG8_SA
#undef PG8_SB
#undef PG8_BLDS
#undef PG8_STAGE_B
#undef PG8_STAGE_A
#undef PG8_GOFF
#undef PG8_LD8
#undef PG8_LDA
#undef PG8_LDB
#undef PG8_MMA
#undef PG8_WAIT_V
#undef PG8_SSQ
#undef PG8_SSQ1
#undef PG8_WAIT_L
#undef PG8_BAR
#undef PG8_SCHED
}
}

struct TJob { const float* src; const float* kgain; bf16_t* dst; int K, N, src_col0, ncols, dst_row0, dst_k0, dst_ld, grp, grp_stride, nbatch, src_bstride, dst_bstride; float scale; int item0, fp8, pad; };
constexpr int NJOBS = 28, NJOBS_PRO = 25;
struct Params {
    const float* in[30];
    float* out; unsigned char* ws;
    int ph_lo, ph_hi, n_items_pro, n_items_moe;
    TJob jobs[NJOBS];
};
enum { I_X = 0, I_C, I_CTX, I_CCTX, I_ADAW, I_ADAB, I_N1G, I_N2G, I_WIN, I_WOUT, I_GATEB, I_MNG, I_CQG, I_CKVG, I_WUQ, I_WUKV, I_QG, I_KG, I_LNG, I_LNB, I_WS, I_BS,
       I_FW1, I_FW3, I_FW2, I_RW, I_RB, I_MW1, I_MW3, I_MW2 };

DI void tr_item(const TJob& J, int r, LAS float* scr, int lane) {
    const int nkb = J.K / 64, nnb = (J.ncols + 31) / 32, per = nkb * nnb;
    const int bt = r / per; r -= bt * per;
    const int kb = r / nnb, nb = r % nnb, k0 = 64 * kb, n0 = 32 * nb;
    auto W = J.src + (size_t)bt * J.src_bstride;
    const int n4 = n0 + 4 * (lane & 7); const bool nok = n4 < J.ncols;
    f32x4 wv[8];
#pragma unroll
    for (int i = 0; i < 8; ++i) { const int kk = 8 * i + (lane >> 3); wv[i] = nok ? *(const GAS f32x4*)(W + (size_t)(k0 + kk) * J.N + J.src_col0 + n4) : (f32x4){0.f, 0.f, 0.f, 0.f}; }
#pragma unroll
    for (int i = 0; i < 8; ++i) { const int kk = 8 * i + (lane >> 3); float sc_ = J.scale; if (J.kgain) sc_ *= J.kgain[k0 + kk];
        auto d = scr + kk * 33 + 4 * (lane & 7); d[0] = wv[i][0] * sc_; d[1] = wv[i][1] * sc_; d[2] = wv[i][2] * sc_; d[3] = wv[i][3] * sc_; }
    asm volatile("s_waitcnt lgkmcnt(0)" ::: "memory");
    const int c = lane & 7;
#pragma unroll
    for (int j = 0; j < 4; ++j) { const int nn = (lane >> 3) + 8 * j, ncol = n0 + nn;
        if (ncol < J.ncols) { auto s = scr + (8 * c) * 33 + nn;
            const int drow = J.dst_row0 + (ncol / J.grp) * J.grp_stride + (ncol % J.grp);
            const size_t doff = (size_t)bt * J.dst_bstride + (size_t)drow * J.dst_ld + J.dst_k0 + k0 + 8 * c;
            if (J.fp8) { int w0 = __builtin_amdgcn_cvt_pk_fp8_f32(s[0 * 33], s[1 * 33], 0, false); w0 = __builtin_amdgcn_cvt_pk_fp8_f32(s[2 * 33], s[3 * 33], w0, true);
                int w1 = __builtin_amdgcn_cvt_pk_fp8_f32(s[4 * 33], s[5 * 33], 0, false); w1 = __builtin_amdgcn_cvt_pk_fp8_f32(s[6 * 33], s[7 * 33], w1, true);
                u32x2 o; o.x = (unsigned)w0; o.y = (unsigned)w1; *(GAS u32x2*)((GAS unsigned char*)J.dst + doff) = o; }
            else { u32x4 o; o.x = pk2(s[0 * 33], s[1 * 33]); o.y = pk2(s[2 * 33], s[3 * 33]); o.z = pk2(s[4 * 33], s[5 * 33]); o.w = pk2(s[6 * 33], s[7 * 33]);
                *(GAS u32x4*)(J.dst + doff) = o; } } }
    asm volatile("s_waitcnt lgkmcnt(0)" ::: "memory");
}
DI void run_jobs(const Params& P, int j0, int j1, int item_lo, int nitems, LAS unsigned char* lds, int gw, int NGW, int wave, int lane) {
    LAS float* scr = (LAS float*)(lds + wave * 16384);
    int j = j0;
    for (int it = item_lo + gw; it < nitems; it += NGW) {
        while (j + 1 < j1 && it >= P.jobs[j + 1].item0) ++j;
        tr_item(P.jobs[j], it - P.jobs[j].item0, scr, lane);
    }
}

template <bool ROUTE, bool OUT8 = false, bool IN16 = false>
DI void phase_norm(const Params& P, GAS unsigned char* wsb, int l, int which, int nrows, const GAS void* xlat, const GAS void* xctx, GAS bf16_t* XN, LAS unsigned char* lds, int tid, int wave, int lane, const GAS bf16_t* xadd = nullptr) {
    const GAS float* modl = (const GAS float*)(wsb + WS_MOD) + (size_t)l * 17 * 6144;
    auto gvec = P.in[opq_i(which ? I_N2G : I_N1G)] + l * D;
    const int per_blk = nrows / 256, per_wave = per_blk / 8;
    f32x4 gg[4], aa[4], ss[4]; int cur_midx = -1;
#pragma unroll
    for (int j = 0; j < 4; ++j) gg[j] = ((const GAS f32x4*)gvec)[64 * j + lane];
    LAS float* rw = (LAS float*)lds;
    LAS unsigned* cnt = (LAS unsigned*)(lds + 32768);
    if (ROUTE) {
        auto rwg = P.in[opq_i(I_RW)];
        for (int i = tid; i < 8192; i += 512) { const int col = i >> 3, e = i & 7, j = col >> 8, ln = (col >> 2) & 63, c = col & 3; rw[((((j * 4 + c) * 2 + (e >> 2)) * 64 + ln) << 2) + (e & 3)] = rwg[i]; }
        if (tid < 8) cnt[tid] = 0u;
        __syncthreads();
    }
    float rb[8] = {0.f, 0.f, 0.f, 0.f, 0.f, 0.f, 0.f, 0.f};
    if (ROUTE) { auto rbg = P.in[opq_i(I_RB)];
#pragma unroll
        for (int e = 0; e < 8; ++e) rb[e] = rbg[e]; }
    const int rowb = blockIdx.x * per_blk + wave * per_wave;
    f32x4 qf[4][4]; u32x2 qh[4][4], qa[4][4]; bool ha[4] = {false, false, false, false};
#define NORM_LOAD(slot, ri) do { const int r_ = rowb + (ri); const bool lat_ = r_ < NLAT; const size_t xo_ = lat_ ? (size_t)r_ * D : (size_t)(r_ - NLAT) * D; auto xp_ = lat_ ? xlat : xctx; \
        ha[slot] = IN16 && xadd != nullptr && !lat_; if (ha[slot]) { _Pragma("unroll") for (int j = 0; j < 4; ++j) qa[slot][j] = ((const GAS u32x2*)(xadd + xo_))[64 * j + lane]; } \
        _Pragma("unroll") for (int j = 0; j < 4; ++j) { if constexpr (IN16) qh[slot][j] = ((const GAS u32x2*)((const GAS bf16_t*)xp_ + xo_))[64 * j + lane]; else qf[slot][j] = ((const GAS f32x4*)((const GAS float*)xp_ + xo_))[64 * j + lane]; } } while (0)
    NORM_LOAD(0, 0); if (per_wave > 1) NORM_LOAD(1, 1); if (per_wave > 2) NORM_LOAD(2, 2);
    for (int i3 = 0; i3 < per_wave; i3 += 4) {
#pragma unroll
      for (int sl = 0; sl < 4; ++sl) { const int i = i3 + sl; if (i < per_wave) {
        const int row = rowb + i;
        const bool lat = row < NLAT; const int midx = lat ? (row >> 11) : 16;
        if (i + 3 < per_wave) NORM_LOAD((sl + 3) % 4, i + 3);
        if (midx != cur_midx) { cur_midx = midx; auto mp = modl + (size_t)midx * 6144 + (which ? 3 * D : 0);
#pragma unroll
            for (int j = 0; j < 4; ++j) { ss[j] = ((const GAS f32x4*)mp)[64 * j + lane]; const f32x4 sc = ((const GAS f32x4*)(mp + D))[64 * j + lane]; aa[j] = gg[j] * (sc + 1.0f); } }
        f32x4 v[4]; float s2 = 0.f;
#pragma unroll
        for (int j = 0; j < 4; ++j) { if constexpr (IN16) { const u32x2 xw = qh[sl][j]; v[j] = (f32x4){lo_f(xw.x), hi_f(xw.x), lo_f(xw.y), hi_f(xw.y)};
                if (ha[sl]) { const u32x2 aw = qa[sl][j]; v[j] += (f32x4){lo_f(aw.x), hi_f(aw.x), lo_f(aw.y), hi_f(aw.y)}; } } else v[j] = qf[sl][j];
            s2 += (v[j].x * v[j].x + v[j].y * v[j].y) + (v[j].z * v[j].z + v[j].w * v[j].w); }
        const float r = __builtin_amdgcn_rsqf(wave_sum(s2) * (1.0f / D) + EPS);
        GAS u32x2* o8 = (GAS u32x2*)(XN + (size_t)row * D);
        float lg[8];
        if (ROUTE) {
#pragma unroll
            for (int e = 0; e < 8; ++e) lg[e] = 0.f; }
#pragma unroll
        for (int j = 0; j < 4; ++j) { const f32x4 y = v[j] * r * aa[j] + ss[j];
            if constexpr (OUT8) { int w8 = __builtin_amdgcn_cvt_pk_fp8_f32(y.x * H8_SCALE, y.y * H8_SCALE, 0, false); w8 = __builtin_amdgcn_cvt_pk_fp8_f32(y.z * H8_SCALE, y.w * H8_SCALE, w8, true);
                ((GAS unsigned*)((GAS unsigned char*)XN + (size_t)row * D))[64 * j + lane] = (unsigned)w8; }
            else { u32x2 w; w.x = pk2(y.x, y.y); w.y = pk2(y.z, y.w); o8[64 * j + lane] = w; }
            if (ROUTE) { const LAS f32x4* rp = (const LAS f32x4*)rw + (j * 4) * 2 * 64 + lane;
#pragma unroll
                for (int c = 0; c < 4; ++c) { const f32x4 w0 = rp[(2 * c) * 64], w1 = rp[(2 * c + 1) * 64]; const float yc = y[c];
                    lg[0] += yc * w0.x; lg[1] += yc * w0.y; lg[2] += yc * w0.z; lg[3] += yc * w0.w; lg[4] += yc * w1.x; lg[5] += yc * w1.y; lg[6] += yc * w1.z; lg[7] += yc * w1.w; } } }
        if (ROUTE) {
#pragma unroll
            for (int e = 0; e < 8; ++e) lg[e] += 0.f;
            {
                float a4[4], b2[2], c1;
                { const bool up = (lane & 1) != 0;
#pragma unroll
                    for (int i = 0; i < 4; ++i) { const float snd = up ? lg[i] : lg[4 + i], kp = up ? lg[4 + i] : lg[i]; a4[i] = kp + __shfl_xor(snd, 1); } }
                { const bool up = (lane & 2) != 0;
#pragma unroll
                    for (int i = 0; i < 2; ++i) { const float snd = up ? a4[i] : a4[2 + i], kp = up ? a4[2 + i] : a4[i]; b2[i] = kp + __shfl_xor(snd, 2); } }
                { const bool up = (lane & 4) != 0; const float snd = up ? b2[0] : b2[1], kp = up ? b2[1] : b2[0]; c1 = kp + __shfl_xor(snd, 4); }
                c1 += __shfl_xor(c1, 8); c1 += __shfl_xor(c1, 16); c1 += __shfl_xor(c1, 32);
#pragma unroll
                for (int e = 0; e < 8; ++e) lg[e] = __shfl(c1, ((e >> 2) & 1) | (((e >> 1) & 1) << 1) | ((e & 1) << 2)) + rb[e];
            }
            int i0 = 0; float l0 = lg[0];
#pragma unroll
            for (int e = 1; e < 8; ++e) if (lg[e] > l0) { l0 = lg[e]; i0 = e; }
            int i1 = -1; float l1 = -3.0e38f;
#pragma unroll
            for (int e = 0; e < 8; ++e) if (e != i0 && lg[e] > l1) { l1 = lg[e]; i1 = e; }
            const float g0 = __builtin_amdgcn_rcpf(1.0f + __expf(l1 - l0)), g1 = 1.0f - g0;
            if (lane == 0) { GAS int* ti = (GAS int*)(wsb + WS_TOPI); GAS float* tg = (GAS float*)(wsb + WS_TOPG);
                ti[2 * row] = i0; ti[2 * row + 1] = i1; tg[2 * row] = g0; tg[2 * row + 1] = g1;
                atomicAdd((unsigned*)&cnt[i0], 1u); atomicAdd((unsigned*)&cnt[i1], 1u); }
        }
      } }
    }
#undef NORM_LOAD
    if (ROUTE) { __syncthreads(); if (tid < 8) ((GAS unsigned*)wsb + CW_BCNT)[blockIdx.x * 8 + tid] = cnt[tid]; }
}


DI void phase_norm2_route(const Params& P, GAS unsigned char* wsb, LAS unsigned char* lds, int tid, int wave, int lane) {
    const GAS float* modl = (const GAS float*)(wsb + WS_MOD) + (size_t)17 * 6144;
    auto gvec = P.in[opq_i(I_N2G)] + D;
    const GAS bf16_t* X = (const GAS bf16_t*)(wsb + WS_X3); GAS unsigned char* XN = (GAS unsigned char*)(wsb + WS_XN);
    LAS float* rw = (LAS float*)lds; LAS unsigned* cnt = (LAS unsigned*)(lds + 32768);
    { auto rwg = P.in[opq_i(I_RW)];
        for (int i = tid; i < 8192; i += 512) { const int col = i >> 3, e = i & 7, j = col >> 8, ln = (col >> 2) & 63, c = col & 3; rw[((((j * 4 + c) * 2 + (e >> 2)) * 64 + ln) << 2) + (e & 3)] = rwg[i]; }
        if (tid < 8) cnt[tid] = 0u;
        __syncthreads(); }
    float rb[8]; { auto rbg = P.in[opq_i(I_RB)];
#pragma unroll
        for (int e = 0; e < 8; ++e) rb[e] = rbg[e]; }
    const int rowb = blockIdx.x * 128 + wave * 16;
    f32x4 aa[4], ss[4];
    { auto mp = modl + (size_t)(rowb >> 11) * 6144 + 3 * D;
#pragma unroll
        for (int j = 0; j < 4; ++j) { const f32x4 gg = ((const GAS f32x4*)gvec)[64 * j + lane]; ss[j] = ((const GAS f32x4*)mp)[64 * j + lane]; const f32x4 sc = ((const GAS f32x4*)(mp + D))[64 * j + lane]; aa[j] = gg * (sc + 1.0f); } }
    u32x2 nx[2][4];
#pragma unroll
    for (int q = 0; q < 2; ++q)
#pragma unroll
        for (int j = 0; j < 4; ++j) nx[q][j] = ((const GAS u32x2*)(X + (size_t)(rowb + q) * D))[64 * j + lane];
    for (int st = 0; st < 8; ++st) {
        const int row0 = rowb + 2 * st;
        u32x2 cx[2][4];
#pragma unroll
        for (int q = 0; q < 2; ++q)
#pragma unroll
            for (int j = 0; j < 4; ++j) cx[q][j] = nx[q][j];
        if (st + 1 < 8) {
#pragma unroll
            for (int q = 0; q < 2; ++q)
#pragma unroll
                for (int j = 0; j < 4; ++j) nx[q][j] = ((const GAS u32x2*)(X + (size_t)(row0 + 2 + q) * D))[64 * j + lane]; }
        f32x4 v[2][4]; float s2[2];
#pragma unroll
        for (int q = 0; q < 2; ++q) { s2[q] = 0.f;
#pragma unroll
            for (int j = 0; j < 4; ++j) { const u32x2 xw = cx[q][j]; v[q][j] = (f32x4){lo_f(xw.x), hi_f(xw.x), lo_f(xw.y), hi_f(xw.y)};
                s2[q] += (v[q][j].x * v[q][j].x + v[q][j].y * v[q][j].y) + (v[q][j].z * v[q][j].z + v[q][j].w * v[q][j].w); } }
#pragma unroll
        for (int o = 1; o < 64; o <<= 1) { s2[0] += __shfl_xor(s2[0], o); s2[1] += __shfl_xor(s2[1], o); }
        float lg[2][8];
#pragma unroll
        for (int q = 0; q < 2; ++q)
#pragma unroll
            for (int e = 0; e < 8; ++e) lg[q][e] = 0.f;
        const float r0 = __builtin_amdgcn_rsqf(s2[0] * (1.0f / D) + EPS), r1 = __builtin_amdgcn_rsqf(s2[1] * (1.0f / D) + EPS);
#pragma unroll
        for (int j = 0; j < 4; ++j) { const f32x4 y0 = v[0][j] * r0 * aa[j] + ss[j], y1 = v[1][j] * r1 * aa[j] + ss[j];
            { int w8 = __builtin_amdgcn_cvt_pk_fp8_f32(y0.x * H8_SCALE, y0.y * H8_SCALE, 0, false); w8 = __builtin_amdgcn_cvt_pk_fp8_f32(y0.z * H8_SCALE, y0.w * H8_SCALE, w8, true);
                ((GAS unsigned*)(XN + (size_t)row0 * D))[64 * j + lane] = (unsigned)w8; }
            { int w8 = __builtin_amdgcn_cvt_pk_fp8_f32(y1.x * H8_SCALE, y1.y * H8_SCALE, 0, false); w8 = __builtin_amdgcn_cvt_pk_fp8_f32(y1.z * H8_SCALE, y1.w * H8_SCALE, w8, true);
                ((GAS unsigned*)(XN + (size_t)(row0 + 1) * D))[64 * j + lane] = (unsigned)w8; }
            const LAS f32x4* rp = (const LAS f32x4*)rw + (j * 4) * 2 * 64 + lane;
#pragma unroll
            for (int c = 0; c < 4; ++c) { const f32x4 w0 = rp[(2 * c) * 64], w1 = rp[(2 * c + 1) * 64]; const float ya = y0[c], yb = y1[c];
                lg[0][0] += ya * w0.x; lg[0][1] += ya * w0.y; lg[0][2] += ya * w0.z; lg[0][3] += ya * w0.w; lg[0][4] += ya * w1.x; lg[0][5] += ya * w1.y; lg[0][6] += ya * w1.z; lg[0][7] += ya * w1.w;
                lg[1][0] += yb * w0.x; lg[1][1] += yb * w0.y; lg[1][2] += yb * w0.z; lg[1][3] += yb * w0.w; lg[1][4] += yb * w1.x; lg[1][5] += yb * w1.y; lg[1][6] += yb * w1.z; lg[1][7] += yb * w1.w; } }
        {
            float a4[2][4], b2[2][2], c1[2];
            { const bool up = (lane & 1) != 0;
#pragma unroll
                for (int q = 0; q < 2; ++q)
#pragma unroll
                    for (int i = 0; i < 4; ++i) { const float snd = up ? lg[q][i] : lg[q][4 + i], kp = up ? lg[q][4 + i] : lg[q][i]; a4[q][i] = kp + __shfl_xor(snd, 1); } }
            { const bool up = (lane & 2) != 0;
#pragma unroll
                for (int q = 0; q < 2; ++q)
#pragma unroll
                    for (int i = 0; i < 2; ++i) { const float snd = up ? a4[q][i] : a4[q][2 + i], kp = up ? a4[q][2 + i] : a4[q][i]; b2[q][i] = kp + __shfl_xor(snd, 2); } }
            { const bool up = (lane & 4) != 0;
#pragma unroll
                for (int q = 0; q < 2; ++q) { const float snd = up ? b2[q][0] : b2[q][1], kp = up ? b2[q][1] : b2[q][0]; c1[q] = kp + __shfl_xor(snd, 4); } }
#pragma unroll
            for (int o = 8; o < 64; o <<= 1) { c1[0] += __shfl_xor(c1[0], o); c1[1] += __shfl_xor(c1[1], o); }
#pragma unroll
            for (int q = 0; q < 2; ++q)
#pragma unroll
                for (int e = 0; e < 8; ++e) lg[q][e] = __shfl(c1[q], ((e >> 2) & 1) | (((e >> 1) & 1) << 1) | ((e & 1) << 2)) + rb[e];
        }
#pragma unroll
        for (int q = 0; q < 2; ++q) { const int row = row0 + q;
            int i0 = 0; float l0 = lg[q][0];
#pragma unroll
            for (int e = 1; e < 8; ++e) if (lg[q][e] > l0) { l0 = lg[q][e]; i0 = e; }
            int i1 = -1; float l1 = -3.0e38f;
#pragma unroll
            for (int e = 0; e < 8; ++e) if (e != i0 && lg[q][e] > l1) { l1 = lg[q][e]; i1 = e; }
            const float g0 = __builtin_amdgcn_rcpf(1.0f + __expf(l1 - l0)), g1 = 1.0f - g0;
            if (lane == 0) { GAS int* ti = (GAS int*)(wsb + WS_TOPI); GAS float* tg = (GAS float*)(wsb + WS_TOPG);
                ti[2 * row] = i0; ti[2 * row + 1] = i1; tg[2 * row] = g0; tg[2 * row + 1] = g1;
                atomicAdd((unsigned*)&cnt[i0], 1u); atomicAdd((unsigned*)&cnt[i1], 1u); } }
    }
    __syncthreads(); if (tid < 8) ((GAS unsigned*)wsb + CW_BCNT)[blockIdx.x * 8 + tid] = cnt[tid];
}

DI void phase_prep(const Params& P, GAS unsigned char* wsb, int l, int gw, int NGW, int lane) {
    const GAS bf16_t* Z = (const GAS bf16_t*)(wsb + WS_Z); GAS bf16_t* VLN = (GAS bf16_t*)(wsb + WS_VLN);
    const f32x4 lg = ((const GAS f32x4*)(P.in[opq_i(I_LNG)] + l * 256))[lane], lb = ((const GAS f32x4*)(P.in[opq_i(I_LNB)] + l * 256))[lane];
    const int nrows = l == 0 ? NTOK : NLAT;
#define PREP_LD(r_) ((r_) < nrows ? *(const GAS u32x2*)(Z + (size_t)(r_) * ZW + ZGV + 4 * lane) : (u32x2){0u, 0u})
    constexpr int NR = 4;
    u32x2 gn[NR];
#pragma unroll
    for (int q = 0; q < NR; ++q) gn[q] = PREP_LD(gw + q * NGW);
    for (int row = gw; row < nrows; row += NR * NGW) {
        u32x2 g[NR]; float a[NR][4], sm[NR], vr[NR];
#pragma unroll
        for (int q = 0; q < NR; ++q) g[q] = gn[q];
#pragma unroll
        for (int q = 0; q < NR; ++q) gn[q] = PREP_LD(row + (NR + q) * NGW);
#pragma unroll
        for (int q = 0; q < NR; ++q) { a[q][0] = gelu_tanh(lo_f(g[q].x)); a[q][1] = gelu_tanh(hi_f(g[q].x)); a[q][2] = gelu_tanh(lo_f(g[q].y)); a[q][3] = gelu_tanh(hi_f(g[q].y)); sm[q] = (a[q][0] + a[q][1]) + (a[q][2] + a[q][3]); }
#pragma unroll
        for (int o = 1; o < 64; o <<= 1) {
#pragma unroll
            for (int q = 0; q < NR; ++q) sm[q] += __shfl_xor(sm[q], o); }
#pragma unroll
        for (int q = 0; q < NR; ++q) { const float mu = sm[q] * (1.0f / 256.0f);
#pragma unroll
            for (int e = 0; e < 4; ++e) a[q][e] -= mu;
            vr[q] = (a[q][0] * a[q][0] + a[q][1] * a[q][1]) + (a[q][2] * a[q][2] + a[q][3] * a[q][3]); }
#pragma unroll
        for (int o = 1; o < 64; o <<= 1) {
#pragma unroll
            for (int q = 0; q < NR; ++q) vr[q] += __shfl_xor(vr[q], o); }
#pragma unroll
        for (int q = 0; q < NR; ++q) { const int r_ = row + q * NGW; const float rs = __builtin_amdgcn_rsqf(vr[q] * (1.0f / 256.0f) + EPS);
            if (r_ < nrows) { u32x2 o; o.x = pk2(a[q][0] * rs * lg.x + lb.x, a[q][1] * rs * lg.y + lb.y); o.y = pk2(a[q][2] * rs * lg.z + lb.z, a[q][3] * rs * lg.w + lb.w);
                *(GAS u32x2*)(VLN + (size_t)r_ * 256 + 4 * lane) = o; } }
    }
#undef PREP_LD
}

DI void phase_qk(const Params& P, GAS unsigned char* wsb, int l, int gw, int NGW, int lane) {
    const GAS bf16_t* Z = (const GAS bf16_t*)(wsb + WS_Z); const GAS bf16_t* QKV = (const GAS bf16_t*)(wsb + WS_QKV); GAS bf16_t* KF = (GAS bf16_t*)(wsb + WS_KF);
    const int hd = lane >> 3, sub = lane & 7;
    auto kg = P.in[opq_i(I_KG)] + l * 96;
    float kgn[8], kgr[4];
#pragma unroll
    for (int j = 0; j < 8; ++j) kgn[j] = kg[sub * 8 + j];
    kgr[0] = kg[64 + 2 * sub]; kgr[1] = kg[64 + 2 * sub + 1]; kgr[2] = kg[80 + 2 * sub]; kgr[3] = kg[80 + 2 * sub + 1];
    const int i0 = 2 * sub, i1 = 2 * sub + 1;
    const float inv0 = __powf(10000.0f, -(float)(i0 & 7) * 0.125f), inv1 = __powf(10000.0f, -(float)(i1 & 7) * 0.125f);
    constexpr int NRK = 8;
#define QK_LOAD(row_, ka_, k0_, k1_) do { if ((row_) < NTOK) { auto qr_ = QKV + (size_t)(row_) * UPN; auto zr_ = Z + (size_t)(row_) * ZW + ZKR; \
        ka_ = *(const GAS u32x4*)(qr_ + 768 + hd * 128 + sub * 8); k0_ = *(const GAS unsigned*)(zr_ + 2 * sub); k1_ = *(const GAS unsigned*)(zr_ + 16 + 2 * sub); } } while (0)
    u32x4 nka[NRK]; unsigned nk0[NRK], nk1[NRK];
#pragma unroll
    for (int q = 0; q < NRK; ++q) { nka[q] = (u32x4){0u, 0u, 0u, 0u}; nk0[q] = 0u; nk1[q] = 0u; }
#pragma unroll
    for (int q = 0; q < NRK; ++q) QK_LOAD(gw + q * NGW, nka[q], nk0[q], nk1[q]);
    for (int row0 = gw; row0 < NTOK; row0 += NRK * NGW) {
        u32x4 cka[NRK]; unsigned ck0[NRK], ck1[NRK];
#pragma unroll
        for (int q = 0; q < NRK; ++q) { cka[q] = nka[q]; ck0[q] = nk0[q]; ck1[q] = nk1[q]; }
#pragma unroll
        for (int q = 0; q < NRK; ++q) QK_LOAD(row0 + (NRK + q) * NGW, nka[q], nk0[q], nk1[q]);
        float x[NRK][8], t1a[NRK], t1b[NRK], t2a[NRK], t2b[NRK], ssq[NRK];
#pragma unroll
        for (int q = 0; q < NRK; ++q) { const u32x4 a = cka[q];
            x[q][0] = lo_f(a.x); x[q][1] = hi_f(a.x); x[q][2] = lo_f(a.y); x[q][3] = hi_f(a.y); x[q][4] = lo_f(a.z); x[q][5] = hi_f(a.z); x[q][6] = lo_f(a.w); x[q][7] = hi_f(a.w);
            t1a[q] = lo_f(ck0[q]); t1b[q] = hi_f(ck0[q]); t2a[q] = lo_f(ck1[q]); t2b[q] = hi_f(ck1[q]);
            ssq[q] = t1a[q] * t1a[q] + t1b[q] * t1b[q] + t2a[q] * t2a[q] + t2b[q] * t2b[q];
#pragma unroll
            for (int j = 0; j < 8; ++j) ssq[q] += x[q][j] * x[q][j]; }
#pragma unroll
        for (int o = 1; o < 8; o <<= 1) {
#pragma unroll
            for (int q = 0; q < NRK; ++q) ssq[q] += __shfl_xor(ssq[q], o); }
#pragma unroll
        for (int q = 0; q < NRK; ++q) { const int row = row0 + q * NGW;
            if (row < NTOK) {
                const bool lat = row < NLAT;
                float c0 = 1.f, s0 = 0.f, c1 = 1.f, s1 = 0.f;
                if (lat) { const int s = row & (SEQ - 1); const float pr = (float)(s >> 6), pc = (float)(s & 63);
                    const float a0 = (i0 < 8 ? pr : pc) * inv0, a1 = (i1 < 8 ? pr : pc) * inv1; s0 = __sinf(a0); c0 = __cosf(a0); s1 = __sinf(a1); c1 = __cosf(a1); }
                const float r = __builtin_amdgcn_rsqf(ssq[q] * (1.0f / 96.0f) + EPS);
#pragma unroll
                for (int j = 0; j < 8; ++j) x[q][j] = x[q][j] * r * kgn[j];
                const float u1a = t1a[q] * r * kgr[0], u1b = t1b[q] * r * kgr[1], u2a = t2a[q] * r * kgr[2], u2b = t2b[q] * r * kgr[3];
                const float o1a = u1a * c0 - u2a * s0, o1b = u1b * c1 - u2b * s1, o2a = u1a * s0 + u2a * c0, o2b = u1b * s1 + u2b * c1;
                auto ko = KF + (size_t)row * 768 + hd * 96;
                u32x4 w; w.x = pk2(x[q][0], x[q][1]); w.y = pk2(x[q][2], x[q][3]); w.z = pk2(x[q][4], x[q][5]); w.w = pk2(x[q][6], x[q][7]);
                *(GAS u32x4*)(ko + sub * 8) = w; *(GAS unsigned*)(ko + 64 + 2 * sub) = pk2(o1a, o1b); *(GAS unsigned*)(ko + 80 + 2 * sub) = pk2(o2a, o2b);
            } }
    }
#undef QK_LOAD
}

constexpr int AT_KBUF = 64 * 192, AT_VBUF = 64 * 128;
typedef short s16x4_t __attribute__((ext_vector_type(4)));
DI void phase_attn(const Params& P, GAS unsigned char* wsb, int l, LAS unsigned char* lds, const int tid) {
    const GAS bf16_t* QKV = (const GAS bf16_t*)(wsb + WS_QKV); const GAS bf16_t* KF = (const GAS bf16_t*)(wsb + WS_KF); GAS bf16_t* MIX = (GAS bf16_t*)(wsb + WS_XN);
    const int lane = tid & 63, wave = __builtin_amdgcn_readfirstlane(tid >> 6), fr = lane & 15, fq = lane >> 4;
    const int nunits = l == 0 ? 1152 : 1024, G = gridDim.x;
    const int vcu = (G % 8 == 0) ? (int)(blockIdx.x % 8) * (G / 8) + (int)(blockIdx.x / 8) : (int)blockIdx.x;
    const int kp_a = tid, kp_b = 512 + tid; const int krow_a = kp_a / 12, krow_b = kp_b / 12;
    const int kc_a = ((kp_a % 12) & 12) | (((kp_a % 12) & 3) ^ ((krow_a >> 1) & 3)), kc_b = ((kp_b % 12) & 12) | (((kp_b % 12) & 3) ^ ((krow_b >> 1) & 3));
    const int vrow = tid >> 3, vch = (tid & 7) ^ (2 * ((vrow >> 1) & 3));
    const int tq = (lane >> 2) & 3, tp = lane & 3, vsw = 2 * (fq & 1) + (tq >> 1);
    const int vtoff = 128 * (4 * fq + tq) + 8 * tp;
    auto const KB = lds; auto const VB = lds + 3 * AT_KBUF;
    const int koff = fr * 192 + 16 * (fq ^ ((fr >> 1) & 3));
    LAS float* QGL = (LAS float*)(lds + LDSCTL_OFF + 2048);
    { auto qg = P.in[opq_i(I_QG)] + l * 96; auto kg = P.in[opq_i(I_KG)] + l * 96;
        if (tid < 96) QGL[tid] = qg[tid];
        if (tid < 64) { float m = fmaxf(fabsf(kg[tid]), tid < 32 ? fabsf(kg[64 + tid]) : 0.f); m = wave_max(m); if (tid == 0) QGL[96] = 9.797958971f * m * 1.02f; }
        __syncthreads(); }
#define AT_DECODE(u_, b_, hd_, q0_, nt_, lat_) do { if ((u_) < 1024) { b_ = (u_) >> 6; hd_ = ((u_) >> 3) & 7; q0_ = b_ * SEQ + ((u_) & 7) * 256; nt_ = 36; lat_ = true; } \
        else { const int uu_ = (u_) - 1024; b_ = uu_ >> 3; hd_ = uu_ & 7; q0_ = NLAT + b_ * CTXL; nt_ = 4; lat_ = false; } } while (0)
    int tb = 0; bool pre = false;
    auto const QST = lds + 3 * AT_KBUF + 3 * AT_VBUF + wave * 6144;
    for (int u = vcu; u < nunits; u += G) {
        int b, hd, qrow0, nt; bool lat;
        AT_DECODE(u, b, hd, qrow0, nt, lat);
        const bool hasN = u + G < nunits;
        int bN = 0, hdN = 0, qrow0N = 0, ntN = 4; bool latN = false;
        if (hasN) AT_DECODE(u + G, bN, hdN, qrow0N, ntN, latN);
#define AT_TROW(lat_, b_, t) ((lat_) ? ((t) < 32 ? (b_) * SEQ + 64 * (t) : NLAT + (b_) * CTXL + 64 * ((t) - 32)) : NLAT + (b_) * CTXL + 64 * (t))
        bf16x8 Qf[2][3];
        if (!pre) {
#pragma unroll
            for (int mb = 0; mb < 2; ++mb)
#pragma unroll
                for (int ks = 0; ks < 3; ++ks) Qf[mb][ks] = *(const GAS bf16x8*)(QKV + (size_t)(qrow0 + wave * 32 + mb * 16 + fr) * UPN + hd * 96 + 32 * ks + 8 * fq);
        }
        f32x4 O[2][4], lsum[2]; float mrow[2];
        const bf16x8 ones8 = {(short)0x3F80, (short)0x3F80, (short)0x3F80, (short)0x3F80, (short)0x3F80, (short)0x3F80, (short)0x3F80, (short)0x3F80};
#pragma unroll
        for (int mb = 0; mb < 2; ++mb) { lsum[mb] = (f32x4){0.f, 0.f, 0.f, 0.f};
#pragma unroll
            for (int db = 0; db < 4; ++db) O[mb][db] = (f32x4){0.f, 0.f, 0.f, 0.f}; }
        f32x4 Minit[2];
#define AT_DMA(gp, lp) asm volatile("s_mov_b32 m0, %1\n\ts_nop 0\n\tglobal_load_lds_dwordx4 %0, off" :: "v"(gp), "s"((unsigned)(__UINTPTR_TYPE__)(lp)) : "memory", "m0")
#define AT_LOADK(lat_, b_, hd_, t, bufi) do { const int tr_ = AT_TROW(lat_, b_, t); auto kb_ = KB + (bufi) * AT_KBUF + wave * 1024; \
            AT_DMA(KF + (size_t)(tr_ + krow_a) * 768 + (hd_) * 96 + kc_a * 8, kb_); \
            if (wave < 4) AT_DMA(KF + (size_t)(tr_ + krow_b) * 768 + (hd_) * 96 + kc_b * 8, kb_ + 8192); } while (0)
#define AT_LOADV(lat_, b_, hd_, t, bufi) do { const int tr_ = AT_TROW(lat_, b_, t); \
            AT_DMA(QKV + (size_t)(tr_ + vrow) * UPN + 768 + (hd_) * 128 + 64 + vch * 8, VB + (bufi) * AT_VBUF + wave * 1024); } while (0)
#define AT_VTR(vbase, c, a, db) __builtin_amdgcn_ds_read_tr16_b64_v4i16((LAS s16x4_t*)(vp4_[db] + (4096 * (c) + 2048 * (a))))
#define AT_KFRAG(kbase, nb, ks) (*(const LAS bf16x8*)((kbase) + koff + (nb) * (16 * 192) + (ks) * 64))
#define AT_SINIT(Sx) do { _Pragma("unroll") for (int mb = 0; mb < 2; ++mb) _Pragma("unroll") for (int nb = 0; nb < 4; ++nb) Sx[mb][nb] = (f32x4){mrow[mb], mrow[mb], mrow[mb], mrow[mb]}; } while (0)
#define AT_CHUNK(Sx, i) do { f32x4 p_; _Pragma("unroll") for (int e_ = 0; e_ < 4; ++e_) p_[e_] = __builtin_amdgcn_exp2f(Sx[(i) >> 2][(i) & 3][e_]); Sx[(i) >> 2][(i) & 3] = p_; } while (0)
#define AT_MMA3(Sx, kf, ks, j0) do { _Pragma("unroll") for (int j_ = (j0); j_ < (j0) + 3 && j_ < 8; ++j_) Sx[j_ & 1][j_ >> 1] = __builtin_amdgcn_mfma_f32_16x16x32_bf16(kf[j_ >> 1], Qf[j_ & 1][ks], (ks) == 0 ? Minit[j_ & 1] : Sx[j_ & 1][j_ >> 1], 0, 0, 0); } while (0)
#define AT_SMAX(Sc, c) do { _Pragma("unroll") for (int mb = 0; mb < 2; ++mb) { AT_CHUNK(Sc, 4 * mb + 2 * (c)); AT_CHUNK(Sc, 4 * mb + 2 * (c) + 1); u32x4 w; \
                w.x = pg8::cvt_pk_bf16(Sc[mb][2 * (c)][0], Sc[mb][2 * (c)][1]); w.y = pg8::cvt_pk_bf16(Sc[mb][2 * (c)][2], Sc[mb][2 * (c)][3]); \
                w.z = pg8::cvt_pk_bf16(Sc[mb][2 * (c) + 1][0], Sc[mb][2 * (c) + 1][1]); w.w = pg8::cvt_pk_bf16(Sc[mb][2 * (c) + 1][2], Sc[mb][2 * (c) + 1][3]); Pf[mb][c] = __builtin_bit_cast(bf16x8, w); } } while (0)
#define AT_SMMA(Sc, nb0) do { _Pragma("unroll") for (int ks = 0; ks < 3; ++ks) _Pragma("unroll") for (int nb = (nb0); nb < (nb0) + 2; ++nb) _Pragma("unroll") for (int mb = 0; mb < 2; ++mb) \
                Sc[mb][nb] = __builtin_amdgcn_mfma_f32_16x16x32_bf16(kf[ks][nb], Qf[mb][ks], ks == 0 ? Minit[mb] : Sc[mb][nb], 0, 0, 0); } while (0)
#define AT_VFR(c) do { _Pragma("unroll") for (int db = 0; db < 4; ++db) { const s16x4_t lo_ = AT_VTR(vb2_, c, 0, db), hi_ = AT_VTR(vb2_, c, 1, db); vfr[c][db] = __builtin_shufflevector(lo_, hi_, 0, 1, 2, 3, 4, 5, 6, 7); } } while (0)
#define AT_PV(c) do { _Pragma("unroll") for (int db = 0; db < 4; ++db) _Pragma("unroll") for (int mb = 0; mb < 2; ++mb) O[mb][db] = __builtin_amdgcn_mfma_f32_16x16x32_bf16(vfr[c][db], Pf[mb][c], O[mb][db], 0, 0, 0); \
            _Pragma("unroll") for (int mb = 0; mb < 2; ++mb) lsum[mb] = __builtin_amdgcn_mfma_f32_16x16x32_bf16(ones8, Pf[mb][c], lsum[mb], 0, 0, 0); } while (0)
#define AT_TILE(Sc, t) do { \
            const int rb_ = (tb + (t)) % 3, rn_ = (tb + (t) + 2) % 3; auto kc_ = KB + rb_ * AT_KBUF; auto vb2_ = VB + rb_ * AT_VBUF; int nis_ = 0; \
            LAS unsigned char* vp4_[4]; _Pragma("unroll") for (int db = 0; db < 4; ++db) vp4_[db] = vb2_ + (vtoff + 32 * (db ^ vsw)); \
            bf16x8 kf[3][4], vfr[2][4], Pf[2][2]; \
            _Pragma("unroll") for (int h = 0; h < 2; ++h) _Pragma("unroll") for (int ks = 0; ks < 3; ++ks) _Pragma("unroll") for (int nb = 2 * h; nb < 2 * h + 2; ++nb) kf[ks][nb] = AT_KFRAG(kc_, nb, ks); \
            if ((t) + 2 < nt) { AT_LOADK(lat, b, hd, (t) + 2, rn_); AT_LOADV(lat, b, hd, (t) + 2, rn_); nis_ = 1; }     \
            else if (hasN) { AT_LOADK(latN, bN, hdN, (t) + 2 - nt, rn_); AT_LOADV(latN, bN, hdN, (t) + 2 - nt, rn_); nis_ = 3; \
                if ((t) == nt - 2) { nis_ = 2; _Pragma("unroll") for (int mb = 0; mb < 2; ++mb) _Pragma("unroll") for (int ks = 0; ks < 3; ++ks) \
                    AT_DMA(QKV + (size_t)(qrow0N + wave * 32 + mb * 16 + fr) * UPN + hdN * 96 + 32 * ks + 8 * fq, QST + (mb * 3 + ks) * 1024); } } \
            __builtin_amdgcn_sched_barrier(0); \
            AT_SMMA(Sc, 0); \
            __builtin_amdgcn_sched_barrier(0); \
            AT_VFR(0); AT_SMMA(Sc, 2); AT_SMAX(Sc, 0); \
            __builtin_amdgcn_sched_group_barrier(0x100, 8, 0); \
            _Pragma("unroll") for (int g_ = 0; g_ < 12; ++g_) { __builtin_amdgcn_sched_group_barrier(0x008, 1, 0); __builtin_amdgcn_sched_group_barrier(0x002, 4, 0); } \
            __builtin_amdgcn_sched_barrier(0); \
            AT_VFR(1); AT_PV(0); AT_SMAX(Sc, 1); \
            __builtin_amdgcn_sched_group_barrier(0x100, 8, 0); \
            _Pragma("unroll") for (int g_ = 0; g_ < 10; ++g_) { __builtin_amdgcn_sched_group_barrier(0x008, 1, 0); __builtin_amdgcn_sched_group_barrier(0x002, 4, 0); } \
            __builtin_amdgcn_sched_barrier(0); \
            AT_PV(1); \
            __builtin_amdgcn_sched_barrier(0); \
              \
            if (nis_ == 1) { if (wave < 4) asm volatile("s_waitcnt vmcnt(3)" ::: "memory"); else asm volatile("s_waitcnt vmcnt(2)" ::: "memory"); } \
            else if (nis_ == 2) { if (wave < 4) asm volatile("s_waitcnt vmcnt(9)" ::: "memory"); else asm volatile("s_waitcnt vmcnt(8)" ::: "memory"); }     \
            else if (nis_ == 0) asm volatile("s_waitcnt vmcnt(0)" ::: "memory");     \
            __syncthreads(); } while (0)
        if (!pre) { __syncthreads();
            AT_LOADK(lat, b, hd, 0, tb % 3); AT_LOADV(lat, b, hd, 0, tb % 3); AT_LOADK(lat, b, hd, 1, (tb + 1) % 3); AT_LOADV(lat, b, hd, 1, (tb + 1) % 3); }
        else {
            asm volatile("s_waitcnt vmcnt(2)" ::: "memory");
#pragma unroll
            for (int mb = 0; mb < 2; ++mb)
#pragma unroll
                for (int ks = 0; ks < 3; ++ks) Qf[mb][ks] = *(const LAS bf16x8*)(QST + (mb * 3 + ks) * 1024 + lane * 16);
        }
        {
            const float kbound = QGL[96];
            f32x4 g4[3][2];
#pragma unroll
            for (int ks = 0; ks < 3; ++ks) { g4[ks][0] = *(const LAS f32x4*)(QGL + 32 * ks + 8 * fq); g4[ks][1] = *(const LAS f32x4*)(QGL + 32 * ks + 8 * fq + 4); }
            const float INV[8] = {1.0f, 0.31622776601683794f, 0.1f, 0.031622776601683794f, 0.01f, 0.0031622776601683794f, 0.001f, 0.00031622776601683794f};
#pragma unroll
            for (int mb = 0; mb < 2; ++mb) {
                const int row = qrow0 + wave * 32 + mb * 16 + fr;
                float x[3][8]; float ssq = 0.f;
#pragma unroll
                for (int ks = 0; ks < 3; ++ks) { const u32x4 w = __builtin_bit_cast(u32x4, Qf[mb][ks]);
                    x[ks][0] = lo_f(w.x); x[ks][1] = hi_f(w.x); x[ks][2] = lo_f(w.y); x[ks][3] = hi_f(w.y); x[ks][4] = lo_f(w.z); x[ks][5] = hi_f(w.z); x[ks][6] = lo_f(w.w); x[ks][7] = hi_f(w.w);
#pragma unroll
                    for (int j = 0; j < 8; ++j) ssq += x[ks][j] * x[ks][j]; }
                ssq += __shfl_xor(ssq, 16); ssq += __shfl_xor(ssq, 32);
                const float r = __builtin_amdgcn_rsqf(ssq * (1.0f / 96.0f) + EPS);
#pragma unroll
                for (int ks = 0; ks < 2; ++ks)
#pragma unroll
                    for (int j = 0; j < 8; ++j) x[ks][j] = x[ks][j] * r * g4[ks][j >> 2][j & 3] * QSCALE;
                const int sq = row & (SEQ - 1); const float pos = (float)((fq & 1) == 0 ? (sq >> 6) : (sq & 63));
#pragma unroll
                for (int j = 0; j < 8; ++j) { const float tt = x[2][j] * r * g4[2][j >> 2][j & 3]; float o = tt;
                    if (lat) { const float ang = pos * INV[j], sn = __sinf(ang), cs = __cosf(ang); const float other = __shfl_xor(tt, 32); o = fq < 2 ? tt * cs - other * sn : other * sn + tt * cs; }
                    x[2][j] = o * QSCALE; }
                float qq = 0.f;
#pragma unroll
                for (int ks = 0; ks < 3; ++ks) { u32x4 w; w.x = pg8::cvt_pk_bf16(x[ks][0], x[ks][1]); w.y = pg8::cvt_pk_bf16(x[ks][2], x[ks][3]); w.z = pg8::cvt_pk_bf16(x[ks][4], x[ks][5]); w.w = pg8::cvt_pk_bf16(x[ks][6], x[ks][7]); Qf[mb][ks] = __builtin_bit_cast(bf16x8, w);
#pragma unroll
                    for (int j = 0; j < 8; ++j) qq += x[ks][j] * x[ks][j]; }
                qq += __shfl_xor(qq, 16); qq += __shfl_xor(qq, 32);
                mrow[mb] = -sqrtf(qq) * kbound;
            }
        }
        Minit[0] = (f32x4){mrow[0], mrow[0], mrow[0], mrow[0]}; Minit[1] = (f32x4){mrow[1], mrow[1], mrow[1], mrow[1]};
        if (!pre) asm volatile("s_waitcnt vmcnt(0)" ::: "memory");
        __syncthreads();
        f32x4 SA[2][4];
        for (int t = 0; t < nt; ++t) AT_TILE(SA, t);
        tb = (tb + nt) % 3; pre = hasN;
#pragma unroll
        for (int mb = 0; mb < 2; ++mb) { const float lt = lsum[mb][0]; const float inv = __builtin_amdgcn_rcpf(lt);
            auto orow = MIX + (size_t)(qrow0 + wave * 32 + mb * 16 + fr) * D + 256 + hd * 64 + 4 * fq;
#pragma unroll
            for (int db = 0; db < 4; ++db) { const f32x4 o = O[mb][db] * inv; u32x2 w; w.x = pg8::cvt_pk_bf16(o[0], o[1]); w.y = pg8::cvt_pk_bf16(o[2], o[3]); *(GAS u32x2*)(orow + 16 * db) = w; } }
#undef AT_TROW
#undef AT_LOADK
#undef AT_DMA
#undef AT_LOADV
#undef AT_VTR
#undef AT_KFRAG
#undef AT_SINIT
#undef AT_CHUNK
#undef AT_MMA3
#undef AT_TILE
#undef AT_SMAX
#undef AT_SMMA
#undef AT_VFR
#undef AT_PV
    }
#undef AT_DECODE
}

constexpr int ML_SLOT = 4224;
DI int ml_chunk_row0(int b, int c) { return c < 2 ? NLAT + b * CTXL + 128 * c : b * SEQ + 128 * (c - 2); }
DI void ml_gate_scan(const GAS bf16_t* Z, int row0, int hd, int dir, float bi, float bfg, int lane, LAS float* U, LAS float* BP, LAS float* CM, float& F, float& umax) {
    auto z0 = Z + (size_t)(row0 + lane) * ZW + ZGA; auto z1 = z0 + (size_t)64 * ZW;
    const float li0 = bf2f(z0[dir * 4 + hd]) + bi, li1 = bf2f(z1[dir * 4 + hd]) + bi;
    const float lf0 = log_sigmoid(bf2f(z0[8 + dir * 4 + hd]) + bfg), lf1 = log_sigmoid(bf2f(z1[8 + dir * 4 + hd]) + bfg);
    float s0 = lf0, s1 = lf1;
#pragma unroll
    for (int o = 1; o < 64; o <<= 1) { const float t0 = __shfl_up(s0, o), t1 = __shfl_up(s1, o); if (lane >= o) { s0 += t0; s1 += t1; } }
    const float tot0 = __shfl(s0, 63), tot1 = __shfl(s1, 63); F = tot0 + tot1; s1 += tot0;
    float b0, b1;
    if (dir == 0) { b0 = s0; b1 = s1; } else { b0 = F - s0 + lf0; b1 = F - s1 + lf1; }
    const float u0 = li0 - b0, u1 = li1 - b1;
    float c0 = u0, c1 = u1;
    if (dir == 0) {
#pragma unroll
        for (int o = 1; o < 64; o <<= 1) { const float t0 = __shfl_up(c0, o), t1 = __shfl_up(c1, o); if (lane >= o) { c0 = fmaxf(c0, t0); c1 = fmaxf(c1, t1); } }
        c1 = fmaxf(c1, __shfl(c0, 63)); umax = __shfl(c1, 63);
    } else {
#pragma unroll
        for (int o = 1; o < 64; o <<= 1) { const float t0 = __shfl_down(c0, o), t1 = __shfl_down(c1, o); if (lane + o < 64) { c0 = fmaxf(c0, t0); c1 = fmaxf(c1, t1); } }
        c0 = fmaxf(c0, __shfl(c1, 0)); umax = __shfl(c0, 0);
    }
    U[lane] = u0; U[lane + 64] = u1; BP[lane] = b0; BP[lane + 64] = b1; CM[lane] = c0; CM[lane + 64] = c1;
}
constexpr int ML_VST = 160;
#define ML_SWZ(row) (32 * (((row) >> 3) & 3))
DI void phase_ml1(const Params& P, GAS unsigned char* wsb, int l, LAS unsigned char* lds, const int tid) {
    const GAS bf16_t* Z = (const GAS bf16_t*)(wsb + WS_Z); GAS float* ST = (GAS float*)(wsb + WS_HD); GAS f32x4* GS = (GAS f32x4*)(wsb + WS_GS);
    const int lane = tid & 63, wave = __builtin_amdgcn_readfirstlane(tid >> 6), fr = lane & 15, fq = lane >> 4;
    LAS float* SCL = (LAS float*)lds; LAS float* GSL = (LAS float*)(lds + 66560);
    auto VT = lds + 4096; auto KT = lds + 4096 + 64 * ML_VST * 2;
    auto gb = P.in[opq_i(I_GATEB)] + l * 16;
    const int nunits = NB * 4 * 18, G = gridDim.x;
    for (int ub = (G == 256 ? (int)((blockIdx.x + 128) & 255) : (int)blockIdx.x); ub < nunits; ub += 4 * G) {
        __syncthreads();
        { const int i = wave >> 1, dir = wave & 1, u = ub + i * G;
            if (u < nunits) { const int c = u % 18, bh = u / 18, hd = bh & 3, b = bh >> 2, row0 = ml_chunk_row0(b, c); float F, um;
                ml_gate_scan(Z, row0, hd, dir, gb[dir * 4 + hd], gb[8 + dir * 4 + hd], lane, GSL + i * 768 + dir * 128, GSL + i * 768 + 256 + dir * 128, GSL + i * 768 + 512 + dir * 128, F, um);
                if (lane == 0) { SCL[2 * i + dir] = um; auto s2 = ST + (size_t)(u * 2 + dir) * ML_SLOT; s2[4160] = F; s2[4161] = F + um; } } }
        __syncthreads();
        for (int idx = tid; idx < 4 * 192; idx += 512) { const int i = idx / 192, u = ub + i * G; if (u < nunits) GS[(size_t)u * 192 + (idx - i * 192)] = ((const LAS f32x4*)GSL)[idx]; }
        const int pp = tid >> 3, dc = tid & 7;
        u32x4 nk0 = {0u, 0u, 0u, 0u}, nk1 = nk0, nv0 = nk0, nv1 = nk0;
#define ML1_LOAD(u_) do { const int c_ = (u_) % 18, bh_ = (u_) / 18; auto zr_ = Z + (size_t)(ml_chunk_row0(bh_ >> 2, c_) + 2 * pp) * ZW + (bh_ & 3) * 64 + 8 * dc; \
            nk0 = *(const GAS u32x4*)(zr_ + ZKA); nk1 = *(const GAS u32x4*)(zr_ + ZW + ZKA); nv0 = *(const GAS u32x4*)(zr_ + ZVA); nv1 = *(const GAS u32x4*)(zr_ + ZW + ZVA); } while (0)
        if (ub < nunits) ML1_LOAD(ub);
        for (int i = 0; i < 4; ++i) {
            const int u = ub + i * G; if (u >= nunits) break;
            const int c = u % 18, bh = u / 18, hd = bh & 3, b = bh >> 2, row0 = ml_chunk_row0(b, c);
            auto sp = ST + (size_t)(u * 2) * ML_SLOT; const LAS float* U = GSL + i * 768; const LAS float* SC = SCL + 2 * i;
            __syncthreads();
            const u32x4 k0 = nk0, k1 = nk1, v0 = nv0, v1 = nv1;
            {
                const float w00 = __expf(U[2 * pp] - SC[0]), w01 = __expf(U[2 * pp + 1] - SC[0]), w10 = __expf(U[128 + 2 * pp] - SC[1]), w11 = __expf(U[128 + 2 * pp + 1] - SC[1]);
                const unsigned ka[4] = {k0.x, k0.y, k0.z, k0.w}, kb[4] = {k1.x, k1.y, k1.z, k1.w}, va[4] = {v0.x, v0.y, v0.z, v0.w}, vb[4] = {v1.x, v1.y, v1.z, v1.w};
#pragma unroll
                for (int j = 0; j < 4; ++j) {
                    const int r0 = (8 * dc + 2 * j) * (ML_VST * 2) + ((pp * 4) ^ ML_SWZ(8 * dc)), r1 = r0 + ML_VST * 2;
                    *(LAS unsigned*)(VT + r0) = (va[j] & 0xffffu) | (vb[j] << 16);
                    *(LAS unsigned*)(VT + r1) = (va[j] >> 16) | (vb[j] & 0xffff0000u);
                    const float a0 = lo_f(ka[j]), a1 = hi_f(ka[j]), b0 = lo_f(kb[j]), b1 = hi_f(kb[j]);
                    *(LAS unsigned*)(KT + r0) = pk2(a0 * w00, b0 * w01); *(LAS unsigned*)(KT + r1) = pk2(a1 * w00, b1 * w01);
                    *(LAS unsigned*)(KT + 64 * ML_VST * 2 + r0) = pk2(a0 * w10, b0 * w11); *(LAS unsigned*)(KT + 64 * ML_VST * 2 + r1) = pk2(a1 * w10, b1 * w11);
                }
            }
            __syncthreads();
            if (i + 1 < 4 && u + G < nunits) ML1_LOAD(u + G);
            {
                const int dir = wave >> 2, eb = wave & 3; auto kt = KT + dir * (64 * ML_VST * 2);
                f32x4 acc[4];
#pragma unroll
                for (int db = 0; db < 4; ++db) acc[db] = (f32x4){0.f, 0.f, 0.f, 0.f};
#pragma unroll
                for (int ks = 0; ks < 4; ++ks) { const bf16x8 af = *(const LAS bf16x8*)(VT + (16 * eb + fr) * (ML_VST * 2) + (((32 * ks + 8 * fq) * 2) ^ ML_SWZ(16 * eb + fr)));
#pragma unroll
                    for (int db = 0; db < 4; ++db) { const bf16x8 bfv = *(const LAS bf16x8*)(kt + (16 * db + fr) * (ML_VST * 2) + (((32 * ks + 8 * fq) * 2) ^ ML_SWZ(16 * db + fr)));
                        acc[db] = __builtin_amdgcn_mfma_f32_16x16x32_bf16(bfv, af, acc[db], 0, 0, 0); } }
                auto cp = sp + (size_t)dir * ML_SLOT + (16 * eb + fr) * 64 + 4 * fq;
#pragma unroll
                for (int db = 0; db < 4; ++db) *(GAS f32x4*)(cp + 16 * db) = acc[db];
                if (tid < 128) { const int d2 = tid >> 6, dd = tid & 63; auto kr = KT + d2 * (64 * ML_VST * 2) + dd * (ML_VST * 2); float sm = 0.f;
#pragma unroll
                    for (int i2 = 0; i2 < 16; ++i2) { const u32x4 t = *(const LAS u32x4*)(kr + 16 * i2); sm += (lo_f(t.x) + hi_f(t.x)) + (lo_f(t.y) + hi_f(t.y)) + (lo_f(t.z) + hi_f(t.z)) + (lo_f(t.w) + hi_f(t.w)); }
                    sp[(size_t)d2 * ML_SLOT + 4096 + dd] = sm; }
            }
        }
    }
}
#undef ML1_LOAD
DI void phase_ml2(GAS unsigned char* wsb, const int tid) {
    GAS float* ST = (GAS float*)(wsb + WS_HD);
    const int total = NB * 4 * 2 * 4160, lane = tid & 63, stride = gridDim.x * 512;
#define ML2_ORD(d_, k_) ((d_) == 0 ? (k_) : ((k_) < 2 ? 1 - (k_) : 19 - (k_)))
#define ML2_LOAD(idx_, c_, f_, m_) do { const int ch_ = (idx_) / 4160, el_ = (idx_) - ch_ * 4160, d_ = ch_ & 1, bh_ = ch_ >> 1; \
        _Pragma("unroll") for (int k = 0; k < 18; ++k) c_[k] = ST[(size_t)((bh_ * 18 + ML2_ORD(d_, k)) * 2 + d_) * ML_SLOT + el_]; \
        if (lane < 18) { auto sp_ = ST + (size_t)((bh_ * 18 + ML2_ORD(d_, lane)) * 2 + d_) * ML_SLOT; f_ = sp_[4160]; m_ = sp_[4161]; } } while (0)
    float cl[18], cn[18]; float fvl = 0.f, mll = 0.f, fvn = 0.f, mln = 0.f;
#pragma unroll
    for (int k = 0; k < 18; ++k) cl[k] = 0.f;
    int idx = blockIdx.x * 512 + tid;
    if (idx < total) ML2_LOAD(idx, cl, fvl, mll);
    for (; idx < total; idx += stride) {
#pragma unroll
        for (int k = 0; k < 18; ++k) cn[k] = cl[k];
        fvn = fvl; mln = mll;
        if (idx + stride < total) ML2_LOAD(idx + stride, cn, fvn, mln);
        const int chain = idx / 4160, el = idx - chain * 4160, dir = chain & 1, bh = chain >> 1;
        float S = 0.f, m = 0.f;
#pragma unroll
        for (int k = 0; k < 18; ++k) { const int c = ML2_ORD(dir, k); auto sp = ST + (size_t)((bh * 18 + c) * 2 + dir) * ML_SLOT;
            sp[el] = S; if (el == 0) sp[4162] = m;
            const float Fk = __int_as_float(__builtin_amdgcn_readlane(__float_as_int(fvl), k)), mk = __int_as_float(__builtin_amdgcn_readlane(__float_as_int(mll), k));
            const float mn = fmaxf(Fk + m, mk); S = __expf(Fk + m - mn) * S + __expf(mk - mn) * cl[k]; m = mn; }
#pragma unroll
        for (int k = 0; k < 18; ++k) cl[k] = cn[k];
        fvl = fvn; mll = mln;
    }
#undef ML2_ORD
#undef ML2_LOAD
}
constexpr int ML_KST = 80;
DI void phase_ml3(const Params& P, GAS unsigned char* wsb, int l, LAS unsigned char* lds0, const int tid0) {
    const GAS bf16_t* Z = (const GAS bf16_t*)(wsb + WS_Z); const GAS float* ST = (const GAS float*)(wsb + WS_HD); GAS bf16_t* MIX = (GAS bf16_t*)(wsb + WS_XN);
    auto mg = P.in[opq_i(I_MNG)] + l * 256;
    const int c_lo = l == 0 ? 0 : 2, ncs = 18 - c_lo, nunits = NB * 4 * ncs;
    const int vblk = gridDim.x == 256 ? (int)(((blockIdx.x & 7) ^ 4) * 32 + (blockIdx.x >> 3)) : (int)blockIdx.x;
#define ML3_IDX(tt_) const int tid = (tt_), lane = tid & 63, wave = __builtin_amdgcn_readfirstlane(tid >> 6), fr = lane & 15, fq = lane >> 4, \
        pos = tid >> 2, q4 = tid & 3, pp = tid >> 3, dc = tid & 7, cdir = tid >> 8, ce = (tid & 255) >> 2, cd0 = (tid & 3) * 16, t = 16 * wave + fr
    u32x4 ka, kb, v0, v1; f32x4 c0, c1, c2, c3, gsv = {0.f, 0.f, 0.f, 0.f}; float nval = 0.f; bf16x8 Qn[2]; u32x2 own[4];
#define ML3_LOAD(u_) do { const int c_ = c_lo + (u_) % ncs, bh_ = (u_) / ncs, hd_ = bh_ & 3, row0_ = ml_chunk_row0(bh_ >> 2, c_); auto sp0_ = ST + (size_t)((bh_ * 18 + c_) * 2) * ML_SLOT; \
        auto zk_ = Z + (size_t)(row0_ + pos) * ZW + ZKA + hd_ * 64 + 16 * q4; ka = *(const GAS u32x4*)zk_; kb = *(const GAS u32x4*)(zk_ + 8); \
        auto zv_ = Z + (size_t)(row0_ + 2 * pp) * ZW + ZVA + hd_ * 64 + 8 * dc; v0 = *(const GAS u32x4*)zv_; v1 = *(const GAS u32x4*)(zv_ + ZW); \
        if (tid < 128) nval = sp0_[(size_t)(tid >> 6) * ML_SLOT + 4096 + (tid & 63)]; else if (tid < 130) nval = sp0_[(size_t)(tid - 128) * ML_SLOT + 4162]; \
        if (tid < 192) gsv = ((const GAS f32x4*)(wsb + WS_GS))[(size_t)(bh_ * 18 + c_) * 192 + tid]; } while (0)
#define ML3_STAGE(base_) do { auto KS_ = (base_) + 4096; auto VT_ = (base_) + 4096 + 128 * ML_KST * 2; \
        *(LAS u32x4*)(KS_ + pos * (ML_KST * 2) + 32 * q4) = ka; *(LAS u32x4*)(KS_ + pos * (ML_KST * 2) + 32 * q4 + 16) = kb; \
        { const unsigned va[4] = {v0.x, v0.y, v0.z, v0.w}, vb[4] = {v1.x, v1.y, v1.z, v1.w}; \
            _Pragma("unroll") for (int j = 0; j < 4; ++j) { const int r0 = (8 * dc + 2 * j) * (ML_VST * 2) + ((pp * 4) ^ ML_SWZ(8 * dc)); \
                *(LAS unsigned*)(VT_ + r0) = (va[j] & 0xffffu) | (vb[j] << 16); *(LAS unsigned*)(VT_ + r0 + ML_VST * 2) = (va[j] >> 16) | (vb[j] & 0xffff0000u); } } \
        } while (0)
#define ML3_STAGEC(base_) do { auto CT_ = (base_) + 45056; u32x4 w0, w1; w0.x = pg8::cvt_pk_bf16(c0[0], c0[1]); w0.y = pg8::cvt_pk_bf16(c0[2], c0[3]); w0.z = pg8::cvt_pk_bf16(c1[0], c1[1]); w0.w = pg8::cvt_pk_bf16(c1[2], c1[3]); \
            w1.x = pg8::cvt_pk_bf16(c2[0], c2[1]); w1.y = pg8::cvt_pk_bf16(c2[2], c2[3]); w1.z = pg8::cvt_pk_bf16(c3[0], c3[1]); w1.w = pg8::cvt_pk_bf16(c3[2], c3[3]); \
            auto cdst = CT_ + cdir * (64 * ML_KST * 2) + ce * (ML_KST * 2) + cd0 * 2; *(LAS u32x4*)cdst = w0; *(LAS u32x4*)(cdst + 16) = w1; } while (0)
#define ML3_LOADQ(u_) do { const int c_ = c_lo + (u_) % ncs, bh_ = (u_) / ncs, hd_ = bh_ & 3, row0_ = ml_chunk_row0(bh_ >> 2, c_); \
        _Pragma("unroll") for (int ks = 0; ks < 2; ++ks) Qn[ks] = *(const GAS bf16x8*)(Z + (size_t)(row0_ + t) * ZW + ZQA + hd_ * 64 + 32 * ks + 8 * fq); \
        _Pragma("unroll") for (int eb = 0; eb < 4; ++eb) own[eb] = *(const GAS u32x2*)(Z + (size_t)(row0_ + t) * ZW + ZOA + hd_ * 64 + 16 * eb + 4 * fq); \
        } while (0)
#define ML3_LOADC(u_) do { const int c_ = c_lo + (u_) % ncs, bh_ = (u_) / ncs, hd_ = bh_ & 3, row0_ = ml_chunk_row0(bh_ >> 2, c_); auto cp_ = ST + (size_t)((bh_ * 18 + c_) * 2 + cdir) * ML_SLOT + ce * 64 + cd0; \
        c0 = *(const GAS f32x4*)cp_; c1 = *(const GAS f32x4*)(cp_ + 4); c2 = *(const GAS f32x4*)(cp_ + 8); c3 = *(const GAS f32x4*)(cp_ + 12); } while (0)
    LAS float* MGL = (LAS float*)(lds0 + LDSCTL_OFF + 1024);
    if (tid0 < 64) ((LAS f32x4*)MGL)[tid0] = ((const GAS f32x4*)mg)[tid0];
    __syncthreads();
    if (vblk < nunits) { ML3_IDX(tid0); ML3_LOAD(vblk); ML3_LOADC(vblk); ML3_LOADQ(vblk); ML3_STAGE(lds0); ML3_STAGEC(lds0); }
    int par = 0;
    for (int u = vblk; u < nunits; u += gridDim.x, par ^= 1) {
        int tl_ = tid0; asm volatile("" : "+v"(tl_)); ML3_IDX(tl_);
        auto lds = lds0 + par * 65536;
        LAS float* U = (LAS float*)lds; LAS float* BP = (LAS float*)(lds + 1024); LAS float* CM = (LAS float*)(lds + 2048);
        LAS float* MIN = (LAS float*)(lds + 3072); LAS float* NV = (LAS float*)(lds + 3200);
        auto KS = lds + 4096; auto VT = lds + 4096 + 128 * ML_KST * 2; auto CT = lds + 45056;
        const int c = c_lo + u % ncs, bh = u / ncs, hd = bh & 3, b = bh >> 2, row0 = ml_chunk_row0(b, c);
        const int trow = row0 + t;
        if (tid < 128) NV[tid] = nval; else if (tid < 130) MIN[tid - 128] = nval;
        if (tid < 192) ((LAS f32x4*)lds)[tid] = gsv;
        bf16x8 Qf[2]; u32x2 ow[4];
#pragma unroll
        for (int ks = 0; ks < 2; ++ks) Qf[ks] = Qn[ks];
#pragma unroll
        for (int eb = 0; eb < 4; ++eb) ow[eb] = own[eb];
        __syncthreads();
        const bool has_next = u + (int)gridDim.x < nunits;
        if (has_next) ML3_LOAD(u + (int)gridDim.x);
        f32x4 H[4];
#pragma unroll
        for (int eb = 0; eb < 4; ++eb) H[eb] = (f32x4){0.f, 0.f, 0.f, 0.f};
#pragma unroll
        for (int dir = 0; dir < 2; ++dir) {
            const float m_in = MIN[dir];
            const float Mt = fmaxf(m_in, CM[dir * 128 + t]);
            f32x4 S[8];
#pragma unroll
            for (int nb = 0; nb < 8; ++nb) S[nb] = (f32x4){0.f, 0.f, 0.f, 0.f};
#pragma unroll
            for (int h = 0; h < 2; ++h) {
                if (dir == 0 ? 4 * h <= wave : 4 * h + 3 >= wave) {
                    bf16x8 kf[4][2];
#pragma unroll
                    for (int n4 = 0; n4 < 4; ++n4)
#pragma unroll
                        for (int ks = 0; ks < 2; ++ks) kf[n4][ks] = *(const LAS bf16x8*)(KS + (16 * (4 * h + n4) + fr) * (ML_KST * 2) + (32 * ks + 8 * fq) * 2);
                    __builtin_amdgcn_sched_barrier(0);
#pragma unroll
                    for (int ks = 0; ks < 2; ++ks)
#pragma unroll
                        for (int n4 = 0; n4 < 4; ++n4) S[4 * h + n4] = __builtin_amdgcn_mfma_f32_16x16x32_bf16(kf[n4][ks], Qf[ks], S[4 * h + n4], 0, 0, 0);
                    __builtin_amdgcn_sched_barrier(0);
                } }
            float den = 0.f;
#pragma unroll
            for (int h = 0; h < 2; ++h) { f32x4 uu[4];
#pragma unroll
                for (int n4 = 0; n4 < 4; ++n4) uu[n4] = *(const LAS f32x4*)(U + dir * 128 + 16 * (4 * h + n4) + 4 * fq);
#pragma unroll
                for (int n4 = 0; n4 < 4; ++n4) { const int nb = 4 * h + n4;
#pragma unroll
                    for (int i = 0; i < 4; ++i) { const int sidx = 16 * nb + 4 * fq + i; const bool ok = dir == 0 ? sidx <= t : sidx >= t;
                        const float p = ok ? S[nb][i] * __expf(uu[n4][i] - Mt) : 0.f; S[nb][i] = p; den += p; } } }
            den += __shfl_xor(den, 16); den += __shfl_xor(den, 32);
            bf16x8 pf[4];
#pragma unroll
            for (int c4 = 0; c4 < 4; ++c4) { u32x4 w; w.x = pg8::cvt_pk_bf16(S[2 * c4][0], S[2 * c4][1]); w.y = pg8::cvt_pk_bf16(S[2 * c4][2], S[2 * c4][3]);
                w.z = pg8::cvt_pk_bf16(S[2 * c4 + 1][0], S[2 * c4 + 1][1]); w.w = pg8::cvt_pk_bf16(S[2 * c4 + 1][2], S[2 * c4 + 1][3]); pf[c4] = __builtin_bit_cast(bf16x8, w); }
            f32x4 N[4];
#pragma unroll
            for (int eb = 0; eb < 4; ++eb) N[eb] = (f32x4){0.f, 0.f, 0.f, 0.f};
#pragma unroll
            for (int c4 = 0; c4 < 4; ++c4) {
                if (dir == 0 ? 2 * c4 <= wave : 2 * c4 + 1 >= wave) {
                    u32x2 vx[4][2];
#pragma unroll
                    for (int eb = 0; eb < 4; ++eb) { auto vp = VT + (16 * eb + fr) * (ML_VST * 2); const int vo = (32 * c4 + 4 * fq) * 2, vs = ML_SWZ(16 * eb + fr);
                        vx[eb][0] = *(const LAS u32x2*)(vp + (vo ^ vs)); vx[eb][1] = *(const LAS u32x2*)(vp + ((vo + 32) ^ vs)); }
#pragma unroll
                    for (int eb = 0; eb < 4; ++eb) { u32x4 vw; vw.x = vx[eb][0].x; vw.y = vx[eb][0].y; vw.z = vx[eb][1].x; vw.w = vx[eb][1].y;
                        N[eb] = __builtin_amdgcn_mfma_f32_16x16x32_bf16(__builtin_bit_cast(bf16x8, vw), pf[c4], N[eb], 0, 0, 0); }
                } }
            bf16x8 cf[4][2]; f32x4 nv[2][2];
#pragma unroll
            for (int eb = 0; eb < 4; ++eb)
#pragma unroll
                for (int ks = 0; ks < 2; ++ks) cf[eb][ks] = *(const LAS bf16x8*)(CT + dir * (64 * ML_KST * 2) + (16 * eb + fr) * (ML_KST * 2) + (32 * ks + 8 * fq) * 2);
#pragma unroll
            for (int ks = 0; ks < 2; ++ks) { auto np = NV + dir * 64 + 32 * ks + 8 * fq; nv[ks][0] = *(const LAS f32x4*)np; nv[ks][1] = *(const LAS f32x4*)(np + 4); }
            __builtin_amdgcn_sched_barrier(0);
            f32x4 QC[4];
#pragma unroll
            for (int eb = 0; eb < 4; ++eb) { QC[eb] = (f32x4){0.f, 0.f, 0.f, 0.f};
#pragma unroll
                for (int ks = 0; ks < 2; ++ks) QC[eb] = __builtin_amdgcn_mfma_f32_16x16x32_bf16(cf[eb][ks], Qf[ks], QC[eb], 0, 0, 0); }
            float qn = 0.f;
#pragma unroll
            for (int ks = 0; ks < 2; ++ks) { const f32x4 n0 = nv[ks][0], n1 = nv[ks][1]; const u32x4 qw = __builtin_bit_cast(u32x4, Qf[ks]);
                qn += lo_f(qw.x) * n0[0] + hi_f(qw.x) * n0[1] + lo_f(qw.y) * n0[2] + hi_f(qw.y) * n0[3] + lo_f(qw.z) * n1[0] + hi_f(qw.z) * n1[1] + lo_f(qw.w) * n1[2] + hi_f(qw.w) * n1[3]; }
            qn += __shfl_xor(qn, 16); qn += __shfl_xor(qn, 32);
            const float a = __expf(m_in - Mt), dent = den + a * qn;
            const float rden = __builtin_amdgcn_rcpf(fmaxf(fabsf(dent), __expf(-(BP[dir * 128 + t] + Mt))));
#pragma unroll
            for (int eb = 0; eb < 4; ++eb) H[eb] = H[eb] + (N[eb] + QC[eb] * a) * rden;
            if (has_next) { if (dir == 0) { ML3_STAGE(lds0 + (par ^ 1) * 65536); ML3_LOADC(u + (int)gridDim.x); } else { ML3_STAGEC(lds0 + (par ^ 1) * 65536); ML3_LOADQ(u + (int)gridDim.x); } }
        }
        float ssq = 0.f;
#pragma unroll
        for (int eb = 0; eb < 4; ++eb) ssq += (H[eb][0] * H[eb][0] + H[eb][1] * H[eb][1]) + (H[eb][2] * H[eb][2] + H[eb][3] * H[eb][3]);
        ssq += __shfl_xor(ssq, 16); ssq += __shfl_xor(ssq, 32);
        const float r = __builtin_amdgcn_rsqf(ssq * (1.0f / 64.0f) + EPS);
#pragma unroll
        for (int eb = 0; eb < 4; ++eb) { const int e0 = hd * 64 + 16 * eb + 4 * fq; const f32x4 g4 = *(const LAS f32x4*)(MGL + e0);
            u32x2 w; w.x = pg8::cvt_pk_bf16(sigmoidf_(lo_f(ow[eb].x)) * (H[eb][0] * r * g4[0]), sigmoidf_(hi_f(ow[eb].x)) * (H[eb][1] * r * g4[1]));
            w.y = pg8::cvt_pk_bf16(sigmoidf_(lo_f(ow[eb].y)) * (H[eb][2] * r * g4[2]), sigmoidf_(hi_f(ow[eb].y)) * (H[eb][3] * r * g4[3]));
            *(GAS u32x2*)(MIX + (size_t)trow * D + e0) = w; }
    }
}

#undef ML3_LOAD
#undef ML3_STAGE
#undef ML3_IDX
#undef ML3_LOADC
#undef ML3_LOADQ
#undef ML3_STAGEC
DI void phase_gmlp(const Params& P, GAS unsigned char* wsb, int l, LAS unsigned char* lds, const int tid) {
    const GAS bf16_t* Z = (const GAS bf16_t*)(wsb + WS_Z); const GAS bf16_t* VLN = (const GAS bf16_t*)(wsb + WS_VLN); GAS bf16_t* MIX = (GAS bf16_t*)(wsb + WS_XN);
    const GAS bf16_t* WSB = (const GAS bf16_t*)(wsb + WS_WS) + (size_t)l * 4 * 128 * 128; auto bsp = P.in[opq_i(I_BS)] + l * 4 * 128;
    const int lane = tid & 63, wave = __builtin_amdgcn_readfirstlane(tid >> 6), fr = lane & 15, fq = lane >> 4;
    auto VT = lds;
    const int nunits = l == 0 ? 288 : 256;
    for (int u = blockIdx.x; u < nunits; u += gridDim.x) {
        const int row0 = u < 256 ? u * 128 : NLAT + (u - 256) * 128;
        const int p = 16 * wave + fr, row = row0 + p;
        __syncthreads();
        u32x4 sv0[4], sv1[4];
#pragma unroll
        for (int i = 0; i < 4; ++i) { const int task = tid + 512 * i, pp = ((task >> 2) & 7) | ((task >> 8) << 3), fc = (task & 3) | (((task >> 5) & 7) << 2);
            auto vr = VLN + (size_t)(row0 + 2 * pp) * 256 + 8 * fc; sv0[i] = *(const GAS u32x4*)vr; sv1[i] = *(const GAS u32x4*)(vr + 256); }
        bf16x8 af[4][4];
#pragma unroll
        for (int ks = 0; ks < 4; ++ks)
#pragma unroll
            for (int g = 0; g < 4; ++g) af[ks][g] = *(const GAS bf16x8*)(WSB + ((size_t)g * 128 + p) * 128 + 32 * ks + 8 * fq);
        u32x2 uwv[4][4]; float bsv[4];
#pragma unroll
        for (int g = 0; g < 4; ++g) { bsv[g] = bsp[g * 128 + p];
#pragma unroll
            for (int nb = 0; nb < 4; ++nb) uwv[g][nb] = *(const GAS u32x2*)(Z + (size_t)row * ZW + ZGU + g * 64 + 16 * nb + 4 * fq); }
#pragma unroll
        for (int i = 0; i < 4; ++i) { const int task = tid + 512 * i, pp = ((task >> 2) & 7) | ((task >> 8) << 3), fc = (task & 3) | (((task >> 5) & 7) << 2);
            const unsigned va[4] = {sv0[i].x, sv0[i].y, sv0[i].z, sv0[i].w}, vb[4] = {sv1[i].x, sv1[i].y, sv1[i].z, sv1[i].w};
#pragma unroll
            for (int j = 0; j < 4; ++j) { const int r0 = (8 * fc + 2 * j) * (ML_VST * 2) + ((pp * 4) ^ ML_SWZ(8 * fc));
                *(LAS unsigned*)(VT + r0) = (va[j] & 0xffffu) | (vb[j] << 16); *(LAS unsigned*)(VT + r0 + ML_VST * 2) = (va[j] >> 16) | (vb[j] & 0xffff0000u); } }
        __syncthreads();
        f32x4 acc[4][4];
#pragma unroll
        for (int g = 0; g < 4; ++g)
#pragma unroll
            for (int nb = 0; nb < 4; ++nb) acc[g][nb] = (f32x4){0.f, 0.f, 0.f, 0.f};
#pragma unroll
        for (int ks = 0; ks < 4; ++ks)
#pragma unroll
            for (int g = 0; g < 4; ++g) {
#pragma unroll
                for (int nb = 0; nb < 4; ++nb) { const bf16x8 bfv = *(const LAS bf16x8*)(VT + (g * 64 + 16 * nb + fr) * (ML_VST * 2) + (((32 * ks + 8 * fq) * 2) ^ ML_SWZ(16 * nb + fr)));
                    acc[g][nb] = __builtin_amdgcn_mfma_f32_16x16x32_bf16(bfv, af[ks][g], acc[g][nb], 0, 0, 0); } }
#pragma unroll
        for (int g = 0; g < 4; ++g) { const float bs = bsv[g];
#pragma unroll
            for (int nb = 0; nb < 4; ++nb) { const int col = g * 64 + 16 * nb + 4 * fq; const u32x2 uw = uwv[g][nb];
                u32x2 w; w.x = pg8::cvt_pk_bf16(gelu_tanh(lo_f(uw.x)) * (acc[g][nb][0] + bs), gelu_tanh(hi_f(uw.x)) * (acc[g][nb][1] + bs));
                w.y = pg8::cvt_pk_bf16(gelu_tanh(lo_f(uw.y)) * (acc[g][nb][2] + bs), gelu_tanh(hi_f(uw.y)) * (acc[g][nb][3] + bs));
                *(GAS u32x2*)(MIX + (size_t)row * D + 768 + col) = w; } }
    }
}

DI void phase_route(const Params& P, GAS unsigned char* wsb, LAS unsigned char* lds, const int tid) {
    LAS int* tot = (LAS int*)lds; auto pre = tot + 8; auto base = tot + 16; auto wcn = tot + 32;
    const GAS unsigned* bc = (const GAS unsigned*)wsb + CW_BCNT; const GAS int* ti = (const GAS int*)(wsb + WS_TOPI);
    GAS int* tokslot = (GAS int*)(wsb + WS_TOKSLOT); GAS int* slottok = (GAS int*)(wsb + WS_SLOTTOK);
    const int blk = blockIdx.x;
    {
        const int e = tid >> 6, ln = tid & 63; int t = 0, p = 0;
#pragma unroll
        for (int i = 0; i < 4; ++i) { const int c = ln + 64 * i; const int v = (int)bc[c * 8 + e]; t += v; p += c < blk ? v : 0; }
        t = wave_sum_i(t); p = wave_sum_i(p);
        if (ln == 0) { tot[e] = t; pre[e] = p; } }
    const int wv = tid >> 6, ln = tid & 63; int myE = -1, rk = 0;
    if (tid < 256) { myE = ti[(blk * 128) * 2 + tid];
#pragma unroll
        for (int x = 0; x < 8; ++x) { const unsigned long long m = __ballot(myE == x); if (myE == x) rk = __popcll(m & ((1ull << ln) - 1ull)); if (ln == 0) wcn[wv * 8 + x] = __popcll(m); } }
    __syncthreads();
    if (tid == 0) { int s = 0; for (int e = 0; e < 8; ++e) { base[e] = s; s += (tot[e] + 255) & ~255; } base[8] = s; }
    __syncthreads();
    if (tid < 256) { const int e = myE; int rank = rk; for (int w2 = 0; w2 < wv; ++w2) rank += wcn[w2 * 8 + e];
        const int slot = base[e] + pre[e] + rank; const int token = blk * 128 + (tid >> 1);
        slottok[slot] = token; tokslot[token * 2 + (tid & 1)] = slot; }
    if (blk < 8) { const int e = blk; for (int s = base[e] + tot[e] + tid; s < base[e + 1]; s += 512) slottok[s] = 0; }
    if (blk == 0) { GAS unsigned* cw = (GAS unsigned*)wsb;
        if (tid == 0) cw[CW_NT] = (unsigned)(base[8] >> 8);
        if (tid < 7) cw[CW_TEXP + tid] = (unsigned)(base[tid + 1] >> 8);
 }
}

DI u32x2 cb_add4(u32x2 a, u32x2 b) { u32x2 r; r.x = pk2(lo_f(a.x) + lo_f(b.x), hi_f(a.x) + hi_f(b.x)); r.y = pk2(lo_f(a.y) + lo_f(b.y), hi_f(a.y) + hi_f(b.y)); return r; }
DI void phase_combine(const Params& P, GAS unsigned char* wsb, int gw, int NGW, int lane, int mode, int slot_lim, int rbeg = 0, int rend = NLAT) {
    const GAS float* modl = (const GAS float*)(wsb + WS_MOD) + (size_t)1 * 17 * 6144;
    const GAS int* tokslot = (const GAS int*)(wsb + WS_TOKSLOT); const GAS float* tg = (const GAS float*)(wsb + WS_TOPG); const GAS bf16_t* Y = (const GAS bf16_t*)(wsb + WS_Y); const GAS bf16_t* Y2 = (const GAS bf16_t*)(wsb + WS_Y2);
    u32x2 y0c[4], y1c[4], xc[4]; float w0c = 0.f, w1c = 0.f; int s0n = 0, s1n = 0; float w0n = 0.f, w1n = 0.f; bool curp = false;
#define CB_IDX(row_) do { s0n = tokslot[2 * (row_)]; s1n = tokslot[2 * (row_) + 1]; w0n = tg[2 * (row_)]; w1n = tg[2 * (row_) + 1]; } while (0)
#define CB_PRED() (((__builtin_amdgcn_readfirstlane(s0n) < slot_lim) && (__builtin_amdgcn_readfirstlane(s1n) < slot_lim)) == (mode == 1))
#define CB_ROWS(row_, ya, yb, xx) do { const GAS u32x2* x3_ = (const GAS u32x2*)((const GAS bf16_t*)(wsb + WS_X3) + (size_t)(row_) * D); \
        _Pragma("unroll") for (int j = 0; j < 4; ++j) { const int c4 = 64 * j + lane; ya[j] = *(const GAS u32x2*)(Y + (size_t)s0n * D + 4 * c4); yb[j] = *(const GAS u32x2*)(Y + (size_t)s1n * D + 4 * c4); xx[j] = x3_[c4]; } \
        if (__builtin_amdgcn_readfirstlane(s0n) >= MOE_SPLIT_ROW0) { _Pragma("unroll") for (int j = 0; j < 4; ++j) ya[j] = cb_add4(ya[j], *(const GAS u32x2*)(Y2 + (size_t)(s0n - MOE_SPLIT_ROW0) * D + 4 * (64 * j + lane))); } \
        if (__builtin_amdgcn_readfirstlane(s1n) >= MOE_SPLIT_ROW0) { _Pragma("unroll") for (int j = 0; j < 4; ++j) yb[j] = cb_add4(yb[j], *(const GAS u32x2*)(Y2 + (size_t)(s1n - MOE_SPLIT_ROW0) * D + 4 * (64 * j + lane))); } } while (0)
#pragma unroll
    for (int j = 0; j < 4; ++j) { y0c[j] = (u32x2){0u, 0u}; y1c[j] = (u32x2){0u, 0u}; xc[j] = (u32x2){0u, 0u}; }
    const int rpw = (rend - rbeg + NGW - 1) / NGW, rlo = rbeg + gw * rpw, rhi = rlo + rpw < rend ? rlo + rpw : rend;
    f32x4 gvv[4]; int gb = -1;
    if (rlo < rhi) { CB_IDX(rlo); curp = CB_PRED(); if (curp) CB_ROWS(rlo, y0c, y1c, xc); w0c = w0n; w1c = w1n; if (rlo + 1 < rhi) CB_IDX(rlo + 1); }
    for (int row = rlo; row < rhi; ++row) {
        if ((row >> 11) != gb) { gb = row >> 11; auto g2 = modl + (size_t)gb * 6144 + 5 * D;
#pragma unroll
            for (int j = 0; j < 4; ++j) gvv[j] = ((const GAS f32x4*)g2)[64 * j + lane]; }
        u32x2 y0n[4], y1n[4], xn[4]; const float w0x = w0n, w1x = w1n; bool np = false;
#pragma unroll
        for (int j = 0; j < 4; ++j) { y0n[j] = y0c[j]; y1n[j] = y1c[j]; xn[j] = xc[j]; }
        if (row + 1 < rhi) { np = CB_PRED(); if (np) CB_ROWS(row + 1, y0n, y1n, xn); if (row + 2 < rhi) CB_IDX(row + 2); }
        if (curp) {
            GAS f32x4* xr = (GAS f32x4*)(P.out + (size_t)row * D);
#pragma unroll
            for (int j = 0; j < 4; ++j) { const int c4 = 64 * j + lane;
                const u32x2 y0 = y0c[j], y1 = y1c[j];
                const f32x4 gv = gvv[j]; const u32x2 xw = xc[j]; f32x4 x = (f32x4){lo_f(xw.x), hi_f(xw.x), lo_f(xw.y), hi_f(xw.y)};
                x.x += gv.x * (w0c * lo_f(y0.x) + w1c * lo_f(y1.x)); x.y += gv.y * (w0c * hi_f(y0.x) + w1c * hi_f(y1.x));
                x.z += gv.z * (w0c * lo_f(y0.y) + w1c * lo_f(y1.y)); x.w += gv.w * (w0c * hi_f(y0.y) + w1c * hi_f(y1.y));
                xr[c4] = x; }
        }
#pragma unroll
        for (int j = 0; j < 4; ++j) { y0c[j] = y0n[j]; y1c[j] = y1n[j]; xc[j] = xn[j]; }
        w0c = w0x; w1c = w1x; curp = np;
    }
#undef CB_IDX
#undef CB_PRED
#undef CB_ROWS
}

constexpr int NPHASE = 17 + 9 + 2 * NBATCH + 1;
constexpr int MF0 = 0, MF1 = 6656, MF2 = 16856, MF3 = 25176, MF4 = 34776, MF_END = 43008;
#define MOE_FILL(first_short, lo_, hi_) do { if (bid >= (first_short)) { __syncthreads(); run_jobs(P, NJOBS_PRO, NJOBS, (lo_), (hi_) < P.n_items_moe ? (hi_) : P.n_items_moe, lds, (bid - (first_short)) * 8 + wave, (G - (first_short)) * 8, wave, lane); } } while (0)
#define PH_VARS const int wave = opq_i(wave0); const int lane = opq_lane(); const int t_ = wave * 64 + lane; const int gw = blockIdx.x * 8 + wave; \
    auto ws = opq_p(P.ws); const int bid = opq_i((int)blockIdx.x); (void)lane; (void)wave; (void)gw; (void)ws; (void)bid;
__global__ void __launch_bounds__(512, 2) fwd_kernel(Params P) {
    extern __shared__ __attribute__((aligned(16))) unsigned char lds_raw[];
    LAS unsigned char* lds = (LAS unsigned char*)lds_raw;
    const int G = gridDim.x, NGW = G * 8;
    const int wave0 = __builtin_amdgcn_readfirstlane((int)threadIdx.x >> 6);
    volatile LAS unsigned* MISC = (volatile LAS unsigned*)(lds + LDSCTL_OFF);
    if (threadIdx.x < 64) MISC[threadIdx.x] = 0u;
    __syncthreads();
    unsigned* ctl = (unsigned*)P.ws;
    XcdBarrier bar; bar.bar = ctl + CW_BAR; bar.x = 0; bar.st = MISC + 8;
    const bool multi = (P.ph_hi - P.ph_lo) > 1;
    if (multi) bar = xcd_barrier_post(ctl + CW_BAR, MISC + 8);
    const int lo = P.ph_lo, hi = P.ph_hi;
#define IN(k) (lo <= (k) && (k) < hi)
#define SEAM(k) do { if (IN(k) && IN((k) + 1)) { XcdBarrier b2_ = bar; b2_.bar = (unsigned*)opq_p((unsigned char*)bar.bar); xcd_barrier(b2_); } } while (0)

    if (IN(0)) {
        PH_VARS
        const int tid = t_;
        if (blockIdx.x < 192) {
            LAS float* sc = (LAS float*)lds; LAS float* red = (LAS float*)(lds + 69632);
            auto c = P.in[opq_i(I_C)]; auto cc = P.in[opq_i(I_CCTX)];
            for (int i = tid; i < 17 * 1024; i += 512) { const int r = i >> 10, k = i & 1023; const float cv = r < 16 ? c[r * 1024 + k] : cc[k]; sc[i] = cv * __builtin_amdgcn_rcpf(1.0f + __expf(-cv)); }
            __syncthreads();
            const int l = blockIdx.x / 96, j0 = (blockIdx.x % 96) * 64, cg = tid & 15, kgp = tid >> 4, kg = tid >> 6;
            f32x4 acc[17];
#pragma unroll
            for (int r = 0; r < 17; ++r) acc[r] = (f32x4){0.f, 0.f, 0.f, 0.f};
            auto w = P.in[opq_i(I_ADAW)] + (size_t)l * 1024 * 6144 + j0 + 4 * cg;
#pragma unroll 1
            for (int kb = 0; kb < 32; kb += 16) { f32x4 wv[16];
#pragma unroll
                for (int i = 0; i < 16; ++i) wv[i] = *(const GAS f32x4*)(w + (size_t)((kb + i) * 32 + kgp) * 6144);
#pragma unroll
                for (int i = 0; i < 16; ++i) { const int k = (kb + i) * 32 + kgp;
#pragma unroll
                    for (int r = 0; r < 17; ++r) acc[r] += wv[i] * sc[r * 1024 + k]; } }
#pragma unroll
            for (int r = 0; r < 17; ++r) {
#pragma unroll
                for (int e = 0; e < 4; ++e) { float t = acc[r][e]; t += __shfl_xor(t, 16); t += __shfl_xor(t, 32); acc[r][e] = t; }
                if ((tid & 63) < 16) *(LAS f32x4*)(red + (kg * 17 + r) * 64 + 4 * cg) = acc[r]; }
            __syncthreads();
            GAS float* mod = (GAS float*)(ws + WS_MOD);
            for (int o = tid; o < 17 * 64; o += 512) { const int r = o >> 6, c2 = o & 63; float sm = 0.f;
#pragma unroll
                for (int g8 = 0; g8 < 8; ++g8) sm += red[(g8 * 17 + r) * 64 + c2];
                mod[((size_t)l * 17 + r) * 6144 + j0 + c2] = sm + P.in[opq_i(I_ADAB)][l * 6144 + j0 + c2]; }
        }
        __syncthreads();
        run_jobs(P, 0, NJOBS_PRO, 0, P.n_items_pro, lds, gw, NGW, wave, lane);
        { auto wsf = P.in[opq_i(I_WS)]; GAS bf16_t* wsb16 = (GAS bf16_t*)(ws + WS_WS); for (int i = blockIdx.x * 512 + tid; i < 2 * 4 * 128 * 128 / 2; i += G * 512) ((GAS unsigned*)wsb16)[i] = pk2(wsf[2 * i], wsf[2 * i + 1]); }
        for (int l = 0; l < 2; ++l) {
            GAS u32x4* wp = (GAS u32x4*)((GAS bf16_t*)(ws + WS_WIN) + (size_t)l * ZW * D + (size_t)1456 * D);
            for (int i = blockIdx.x * 512 + tid; i < 80 * D / 8; i += G * 512) wp[i] = (u32x4){0u, 0u, 0u, 0u};
        }
    }
    SEAM(0);

    for (int l = 0; l < 2; ++l) {
        const int pb = 1 + 16 * l;
        if (IN(pb + 0)) { PH_VARS
            if (l == 0) phase_norm<false, false, false>(P, ws, 0, 0, NTOK, (const GAS void*)P.in[opq_i(I_X)], (const GAS void*)P.in[opq_i(I_CTX)], (GAS bf16_t*)(ws + WS_XN), lds, t_, wave, lane);
            else phase_norm<false, false, true>(P, ws, 1, 0, NTOK, (const GAS void*)P.out, (const GAS void*)(ws + WS_XC), (GAS bf16_t*)(ws + WS_XN), lds, t_, wave, lane, (const GAS bf16_t*)(ws + WS_P2)); }
        SEAM(pb + 0);
        if (IN(pb + 1)) { PH_VARS
            pg8::Gemm g{(const GAS bf16_t*)(ws + WS_XN), (const GAS bf16_t*)(ws + WS_WIN) + (size_t)l * ZW * D, D, D, nullptr}; pg8::StaticOrder S; S.init(NTOK, ZW, G, bid);
            pg8::EpiBf16 E{(GAS bf16_t*)(ws + WS_Z), ZW, 1.0f};
            pg8::gemm_phase<pg8::EpiBf16, pg8::StaticOrder, false>(lds, g, S, E, t_);
            if (l == 0) MOE_FILL(128, MF0, MF1); else MOE_FILL(128, MF4, MF_END);
        }
        SEAM(pb + 1);
        if (IN(pb + 2)) { PH_VARS
            phase_ml1(P, ws, l, lds, t_); phase_prep(P, ws, l, gw, NGW, lane);
            __syncthreads();
            pg8::Gemm g{(const GAS bf16_t*)(ws + WS_Z) + ZCQ, (const GAS bf16_t*)(ws + WS_BUP) + (size_t)l * UPN * UPK, UPK, ZW, nullptr}; pg8::UpOrder S{G, bid};
            pg8::EpiBf16 E{(GAS bf16_t*)(ws + WS_QKV), UPN, 1.0f};
            pg8::gemm_phase<pg8::EpiBf16, pg8::UpOrder, false>(lds, g, S, E, t_);
        }
        SEAM(pb + 2);
        if (IN(pb + 4)) { PH_VARS
            phase_ml2(ws, t_);
            if (l == 0 && G > 64) { if (bid >= 32) phase_qk(P, ws, l, (bid - 32) * 8 + wave, (G - 32) * 8, lane); } else phase_qk(P, ws, l, gw, NGW, lane);
            phase_gmlp(P, ws, l, lds, t_); }
        SEAM(pb + 4);
        if (IN(pb + 5)) { PH_VARS
            phase_attn(P, ws, l, lds, t_); phase_ml3(P, ws, l, lds, t_); }
        SEAM(pb + 5);
        if (IN(pb + 6)) { PH_VARS
            pg8::Gemm g{(const GAS bf16_t*)(ws + WS_XN), (const GAS bf16_t*)(ws + WS_WOUT) + (size_t)l * D * D, D, D, nullptr}; pg8::StaticOrder S; S.init(l == 0 ? NTOK : NLAT, D, G, bid);
            if (l == 0) { pg8::EpiResidT<true> E{(const GAS void*)P.in[opq_i(I_X)], (const GAS void*)P.in[opq_i(I_CTX)], (GAS bf16_t*)P.out, (GAS bf16_t*)(ws + WS_XC), (const GAS float*)(ws + WS_MOD), 2 * D};
                pg8::gemm_phase<pg8::EpiResidT<true>, pg8::StaticOrder, false>(lds, g, S, E, t_); MOE_FILL(64, MF1, MF2); }
            else { pg8::EpiResidT<false> E{(const GAS void*)P.out, (const GAS void*)(ws + WS_XC), (GAS bf16_t*)(ws + WS_X3), (GAS bf16_t*)(ws + WS_XC), (const GAS float*)(ws + WS_MOD) + (size_t)17 * 6144, 2 * D};
                pg8::gemm_phase<pg8::EpiResidT<false>, pg8::StaticOrder, false>(lds, g, S, E, t_); }
            if (l == 1) { __syncthreads(); run_jobs(P, NJOBS_PRO, NJOBS, MF_END, P.n_items_moe, lds, gw, NGW, wave, lane); }
        }
        SEAM(pb + 6);
        if (IN(pb + 7)) { PH_VARS
            if (l == 0) phase_norm<false, false, true>(P, ws, 0, 1, NTOK, (const GAS void*)P.out, (const GAS void*)(ws + WS_XC), (GAS bf16_t*)(ws + WS_XN), lds, t_, wave, lane);
            else phase_norm2_route(P, ws, lds, t_, wave, lane); }
        SEAM(pb + 7);
        if (l == 0) {
            if (IN(pb + 8)) { PH_VARS
                pg8::Gemm g{(const GAS bf16_t*)(ws + WS_XN), (const GAS bf16_t*)(ws + WS_W13D), D, D, nullptr}; pg8::StaticOrder S; S.init(NTOK, 2 * DFF, G, bid);
                pg8::EpiSwiglu E{(GAS bf16_t*)(ws + WS_G0), DFF, 0, 1.0f};
                pg8::gemm_phase<pg8::EpiSwiglu, pg8::StaticOrder, false, false>(lds, g, S, E, t_);
                MOE_FILL(96, MF2, MF3);
            }
            SEAM(pb + 8);
            if (IN(pb + 9)) { PH_VARS
                pg8::Gemm g{(const GAS bf16_t*)(ws + WS_G0), (const GAS bf16_t*)(ws + WS_W2D), DFF, DFF, nullptr}; pg8::Ffn2Order S{G, bid, DFF / 64};
                pg8::EpiResidS E{{(const GAS void*)P.out, (const GAS void*)(ws + WS_XC), (GAS bf16_t*)P.out, (GAS bf16_t*)(ws + WS_XC), (const GAS float*)(ws + WS_MOD), 5 * D}, (GAS bf16_t*)(ws + WS_P2)};
                pg8::gemm_phase<pg8::EpiResidS, pg8::Ffn2Order, false>(lds, g, S, E, t_);
                MOE_FILL(128, MF3, MF4);
            }
            SEAM(pb + 9);
        } else {
            if (IN(pb + 8)) { PH_VARS
                phase_route(P, ws, lds, t_); }
            SEAM(pb + 8);
            for (int bt = 0; bt < NBATCH; ++bt) {
                if (IN(pb + 9 + 2 * bt)) { PH_VARS
                    const GAS unsigned* cw = (const GAS unsigned*)ws;
                    const int nT = (int)cw[CW_NT]; const int t0 = bt * TB; int n = nT - t0; n = n < 0 ? 0 : (n > TB ? TB : n);
                    pg8::Gemm g{(const GAS bf16_t*)(ws + WS_XN), (const GAS bf16_t*)(ws + WS_W13M), D, D, (const GAS int*)(ws + WS_SLOTTOK)}; pg8::MoeOrder S{t0, n, 2 * DFFE / 256, G, bid, {(int)cw[CW_TEXP], (int)cw[CW_TEXP + 1], (int)cw[CW_TEXP + 2], (int)cw[CW_TEXP + 3], (int)cw[CW_TEXP + 4], (int)cw[CW_TEXP + 5], (int)cw[CW_TEXP + 6]}};
                    pg8::EpiSwiglu8 E{(GAS bf16_t*)(ws + WS_GM), DFFE, t0, 1.0f / (H8_SCALE * W8_SCALE)};
                    pg8::gemm_phase<pg8::EpiSwiglu8, pg8::MoeOrder, true, true>(lds, g, S, E, t_);
                    if (NBATCH > 1 && bt == NBATCH - 1) {
                        const int rem1 = (n * (2 * DFFE / 256)) % G, r0e = rem1 != 0 ? (((G - rem1) * 56) & ~7) : 0;
                        if (rem1 != 0 && bid >= rem1) phase_combine(P, ws, (bid - rem1) * 8 + wave, (G - rem1) * 8, lane, 1, (NBATCH - 1) * TB * 256, 0, r0e < NLAT ? r0e : NLAT);
                    }
                }
                SEAM(pb + 9 + 2 * bt);
                if (IN(pb + 10 + 2 * bt)) { PH_VARS
                    const GAS unsigned* cw = (const GAS unsigned*)ws;
                    const int nT = (int)cw[CW_NT]; const int t0 = bt * TB; int n = nT - t0; n = n < 0 ? 0 : (n > TB ? TB : n);
                    pg8::Gemm g{(const GAS bf16_t*)(ws + WS_GM - (size_t)t0 * 256 * DFFE), (const GAS bf16_t*)(ws + WS_W2M), DFFE, DFFE, nullptr};
                    if (NBATCH > 1 && bt == NBATCH - 1) {
                        const int n1 = n < MOE_FULL ? n : MOE_FULL, n2 = n - n1;
                        pg8::MoeSplitOrder S2{t0, n1, n2, D / 256, G, bid, DFFE / 128, {(int)cw[CW_TEXP], (int)cw[CW_TEXP + 1], (int)cw[CW_TEXP + 2], (int)cw[CW_TEXP + 3], (int)cw[CW_TEXP + 4], (int)cw[CW_TEXP + 5], (int)cw[CW_TEXP + 6]}};
                        pg8::EpiBf16S E2{(GAS bf16_t*)(ws + WS_Y), (GAS bf16_t*)(ws + WS_Y2), D, 1.0f / (G8_SCALE * W28_SCALE), MOE_SPLIT_ROW0};
                        pg8::gemm_phase<pg8::EpiBf16S, pg8::MoeSplitOrder, false, true>(lds, g, S2, E2, t_);
                        const int nu = n1 * (D / 256) + n2 * (D / 256) * 2, rem = nu % G;
                        const int rem1 = (n * (2 * DFFE / 256)) % G, r0x = rem1 != 0 ? (((G - rem1) * 56) & ~7) : 0, r0e = r0x < NLAT ? r0x : NLAT;
                        if (rem == 0) phase_combine(P, ws, gw, NGW, lane, 1, (NBATCH - 1) * TB * 256, r0e, NLAT);
                        else if (bid >= rem) phase_combine(P, ws, (bid - rem) * 8 + wave, (G - rem) * 8, lane, 1, (NBATCH - 1) * TB * 256, r0e, NLAT);
                    } else {
                    pg8::MoeOrder S{t0, n, D / 256, G, bid, {(int)cw[CW_TEXP], (int)cw[CW_TEXP + 1], (int)cw[CW_TEXP + 2], (int)cw[CW_TEXP + 3], (int)cw[CW_TEXP + 4], (int)cw[CW_TEXP + 5], (int)cw[CW_TEXP + 6]}};
                    pg8::EpiBf16 E{(GAS bf16_t*)(ws + WS_Y), D, 1.0f / (G8_SCALE * W28_SCALE)};
                    pg8::gemm_phase<pg8::EpiBf16, pg8::MoeOrder, false, true>(lds, g, S, E, t_);
                    }
                }
                SEAM(pb + 10 + 2 * bt);
            }
            if (IN(pb + 9 + 2 * NBATCH)) { PH_VARS
                phase_combine(P, ws, gw, NGW, lane, 2, NBATCH > 1 ? (NBATCH - 1) * TB * 256 : 0); }
        }
    }
#undef IN
#undef SEAM
}

static void add_job(Params& p, int& nj, int& items, const float* src, const float* kgain, bf16_t* dst, int K, int N, int src_col0, int ncols, int dst_row0, int dst_k0, int dst_ld,
                    int grp, int grp_stride, int nbatch, int src_bstride, int dst_bstride, float scale, int fp8 = 0) {
    TJob& j = p.jobs[nj++];
    j.src = src; j.kgain = kgain; j.dst = dst; j.K = K; j.N = N; j.src_col0 = src_col0; j.ncols = ncols; j.dst_row0 = dst_row0; j.dst_k0 = dst_k0; j.dst_ld = dst_ld;
    j.grp = grp; j.grp_stride = grp_stride; j.nbatch = nbatch; j.src_bstride = src_bstride; j.dst_bstride = dst_bstride; j.scale = scale; j.item0 = items; j.fp8 = fp8;
    items += nbatch * (K / 64) * ((ncols + 31) / 32);
}

extern "C" void kernel_launch(void* const* d_in, const int* in_sizes, int n_in, void* d_out, int out_size, void* d_ws, size_t ws_size, hipStream_t stream) {
    static int grid = 0;
    if (grid == 0) {
        if (n_in != 30 || out_size != NLAT * D || ws_size < WS_END) { fprintf(stderr, "kernel_launch: unexpected shapes (n_in %d out %d ws %zu)\n", n_in, out_size, ws_size); grid = -1; return; }
        int dev = 0, cus = 0;
        if (hipGetDevice(&dev) != hipSuccess || hipDeviceGetAttribute(&cus, hipDeviceAttributeMultiprocessorCount, dev) != hipSuccess) { grid = -1; return; }
        if (hipFuncSetAttribute((const void*)fwd_kernel, hipFuncAttributeMaxDynamicSharedMemorySize, LDS_BYTES) != hipSuccess) { fprintf(stderr, "kernel_launch: hipFuncSetAttribute failed\n"); grid = -1; return; }
        int per_cu = 0;
        if (hipOccupancyMaxActiveBlocksPerMultiprocessor(&per_cu, (const void*)fwd_kernel, 512, LDS_BYTES) != hipSuccess || per_cu < 1) fprintf(stderr, "kernel_launch: occupancy query reports %d\n", per_cu);
        (void)hipGetLastError();
        grid = cus;
        if (grid != 256) { fprintf(stderr, "kernel_launch: built for 256 CUs, got %d\n", grid); grid = -1; return; }
    }
    if (grid < 0) return;
    (void)hipMemsetAsync((char*)d_ws + WS_CTL + (size_t)CW_BAR * 4, 0, 16384, stream);
    Params p{};
    for (int i = 0; i < 30; ++i) p.in[i] = (const float*)d_in[i];
    p.out = (float*)d_out; p.ws = (unsigned char*)d_ws;
    unsigned char* ws = (unsigned char*)d_ws;
    int nj = 0, items = 0; const int BIGG = 1 << 30;
    for (int l = 0; l < 2; ++l) {
        const float* win = p.in[I_WIN] + (size_t)l * D * IN_COLS; bf16_t* wt = (bf16_t*)(ws + WS_WIN) + (size_t)l * ZW * D;
        const int seg[8][3] = {{0, 0, 256}, {256, 256, 256}, {512, 512, 512}, {1024, ZGA, 16}, {1040, ZCQ, 256}, {1296, ZCKV, 128}, {1424, ZKR, 32}, {1456, ZGU, 512}};
        for (int s = 0; s < 8; ++s) add_job(p, nj, items, win, nullptr, wt, D, IN_COLS, seg[s][0], seg[s][2], seg[s][1], 0, D, BIGG, 0, 1, 0, 0, s == 1 ? 0.125f : 1.0f);
        add_job(p, nj, items, p.in[I_WOUT] + (size_t)l * D * D, nullptr, (bf16_t*)(ws + WS_WOUT) + (size_t)l * D * D, D, D, 0, D, 0, 0, D, BIGG, 0, 1, 0, 0, 1.0f);
        bf16_t* bu = (bf16_t*)(ws + WS_BUP) + (size_t)l * UPN * UPK;
        add_job(p, nj, items, p.in[I_WUQ] + (size_t)l * 256 * 768, p.in[I_CQG] + l * 256, bu, 256, 768, 0, 768, 0, 0, UPK, BIGG, 0, 1, 0, 0, 1.0f);
        add_job(p, nj, items, p.in[I_WUKV] + (size_t)l * 128 * 1024, p.in[I_CKVG] + l * 128, bu, 128, 1024, 0, 1024, 768, 256, UPK, BIGG, 0, 1, 0, 0, 1.0f);
    }
    add_job(p, nj, items, p.in[I_FW1], nullptr, (bf16_t*)(ws + WS_W13D), D, DFF, 0, DFF, 0, 0, D, 128, 256, 1, 0, 0, 1.0f, 0);
    add_job(p, nj, items, p.in[I_FW3], nullptr, (bf16_t*)(ws + WS_W13D), D, DFF, 0, DFF, 128, 0, D, 128, 256, 1, 0, 0, 1.0f, 0);
    add_job(p, nj, items, p.in[I_FW2], nullptr, (bf16_t*)(ws + WS_W2D), DFF, D, 0, D, 0, 0, DFF, BIGG, 0, 1, 0, 0, 1.0f);
    p.n_items_pro = items;
    if (nj != NJOBS_PRO) { fprintf(stderr, "job count %d\n", nj); return; }
    items = 0;
    add_job(p, nj, items, p.in[I_MW1], nullptr, (bf16_t*)(ws + WS_W13M), D, DFFE, 0, DFFE, 0, 0, D, 128, 256, NE, D * DFFE, 2 * DFFE * D, W8_SCALE, 1);
    add_job(p, nj, items, p.in[I_MW3], nullptr, (bf16_t*)(ws + WS_W13M), D, DFFE, 0, DFFE, 128, 0, D, 128, 256, NE, D * DFFE, 2 * DFFE * D, W8_SCALE, 1);
    add_job(p, nj, items, p.in[I_MW2], nullptr, (bf16_t*)(ws + WS_W2M), DFFE, D, 0, D, 0, 0, DFFE, BIGG, 0, NE, DFFE * D, D * DFFE, W28_SCALE, 1);
    p.n_items_moe = items;
#if ONE_LAUNCH
    p.ph_lo = 0; p.ph_hi = NPHASE;
    hipLaunchKernelGGL(fwd_kernel, dim3(grid), dim3(512), LDS_BYTES, stream, p);
#else
    for (int ph = 0; ph < NPHASE; ++ph) {
        if ((ph >= 11 && ph < 17) || ph == 4 || ph == 20) continue;
        p.ph_lo = ph; p.ph_hi = ph + 1;
        hipLaunchKernelGGL(fwd_kernel, dim3(grid), dim3(512), LDS_BYTES, stream, p);
#ifdef PROBE_MASK
        if ((PROBE_MASK >> ph) & 1ull) for (int r = 0; r < PROBE_REPS; ++r) hipLaunchKernelGGL(fwd_kernel, dim3(grid), dim3(512), LDS_BYTES, stream, p);
#endif
    }
#endif
}
```
